# Optimizing an MI355X kernel written in HIP

```python
import math
import jax
import jax.numpy as jnp
from jax import lax
import numpy as np

D_MODEL = 2048
BATCH = 4
SEQ = 2048
DEPTH = 4
DEC_BATCH = 8
DEC_SEQ = 4096
PAST_LEN = 128

HEAD_DIM = 128
N_HEADS = D_MODEL // HEAD_DIM
N_KV_HEADS = N_HEADS // 4
GQA_GROUP = N_HEADS // N_KV_HEADS
DIFF_HEADS = D_MODEL // (2 * HEAD_DIM)
DIFF_KV_HEADS = DIFF_HEADS // 2
DIFF_GROUP = DIFF_HEADS // DIFF_KV_HEADS
D_FF = 5504
CONV_WIDTH = 3
BLOCK = 128
WINDOW = 128
BAND = BLOCK + 2 * WINDOW
DILATIONS = ((128, 1), (512, 4), (2048, 16))
GRID_W = 64
ROPE_THETA = 10000.0
N_MIXERS = 4
N_MOD = 6
EPS = 1e-6
NEG_INF = -1e30
QKV_WIDTH = (N_HEADS + 2 * N_KV_HEADS) * HEAD_DIM
DIFF_QKV_WIDTH = (DIFF_HEADS + 2 * DIFF_KV_HEADS) * 2 * HEAD_DIM

kernel_name = "hybrid_bidir_encoder_interleaved"


def _n_uses(m):
    return (DEPTH - m + N_MIXERS - 1) // N_MIXERS


def _lambda_init(layer):
    return 0.8 - 0.6 * math.exp(-0.3 * layer)


def rms_norm(x, g):
    xf = x.astype(jnp.float32)
    y = xf * lax.rsqrt(jnp.mean(xf * xf, axis=-1, keepdims=True) + EPS)
    return (y * g.astype(jnp.float32)).astype(x.dtype)


def alibi_slopes(n):
    return 2.0 ** (-8.0 * jnp.arange(1, n + 1, dtype=jnp.float32) / n)


def project_qkv(h, w, n_q, n_kv, d_qk, d_v):
    B, S, _ = h.shape
    qkv = h @ w
    q = qkv[..., :n_q * d_qk].reshape(B, S, n_q, d_qk)
    k = qkv[..., n_q * d_qk:(n_q + n_kv) * d_qk].reshape(B, S, n_kv, d_qk)
    v = qkv[..., (n_q + n_kv) * d_qk:].reshape(B, S, n_kv, d_v)
    return q, k, v


def to_blocks(x):
    B, S = x.shape[:2]
    return jnp.moveaxis(x.reshape(B, S // BLOCK, BLOCK, *x.shape[2:]), 1, 0)


def from_blocks(x):
    nb, B = x.shape[:2]
    return jnp.moveaxis(x, 0, 1).reshape(B, nb * BLOCK, *x.shape[3:])


def axial_rope_tables(S):
    rows = S // GRID_W
    row = jnp.repeat(jnp.arange(rows, dtype=jnp.float32), GRID_W)
    col = jnp.tile(jnp.arange(GRID_W, dtype=jnp.float32), rows)
    n_freq = HEAD_DIM // 4
    inv_freq = ROPE_THETA ** (-jnp.arange(n_freq, dtype=jnp.float32) / n_freq)
    ang = jnp.stack([row, col], axis=-1)[..., None] * inv_freq
    return jnp.cos(ang), jnp.sin(ang)


def apply_axial_rope(x, cos, sin):
    B, S, H, _ = x.shape
    xr = x.reshape(B, S, H, 2, 2, HEAD_DIM // 4)
    x1, x2 = xr[..., 0, :], xr[..., 1, :]
    c, s = cos[None, :, None], sin[None, :, None]
    out = jnp.stack([x1 * c - x2 * s, x1 * s + x2 * c], axis=-2)
    return out.reshape(B, S, H, HEAD_DIM).astype(x.dtype)


def mixer_a(h, wqkv, q_norm, k_norm, wo):
    B, S, _ = h.shape
    q, k, v = project_qkv(h, wqkv, N_HEADS, N_KV_HEADS, HEAD_DIM, HEAD_DIM)
    cos, sin = axial_rope_tables(S)
    q = apply_axial_rope(rms_norm(q, q_norm), cos, sin) * HEAD_DIM ** -0.5
    k = apply_axial_rope(rms_norm(k, k_norm), cos, sin)
    q = q.reshape(B, S, N_KV_HEADS, GQA_GROUP, HEAD_DIM)

    def block(qi):
        s = jnp.einsum('bqkgd,bskd->bkgqs', qi, k).astype(jnp.float32)
        p = jax.nn.softmax(s, axis=-1).astype(v.dtype)
        return jnp.einsum('bkgqs,bskd->bqkgd', p, v)

    o = from_blocks(lax.map(block, to_blocks(q)))
    return o.reshape(B, S, N_HEADS * HEAD_DIM) @ wo


def mixer_b(h, wqkv, sink, wo):
    B, S, _ = h.shape
    q, k, v = project_qkv(h, wqkv, N_HEADS, N_KV_HEADS, HEAD_DIM, HEAD_DIM)
    q = (q * HEAD_DIM ** -0.5).reshape(B, S, N_KV_HEADS, GQA_GROUP, HEAD_DIM)
    pad = ((0, 0), (WINDOW, WINDOW), (0, 0), (0, 0))
    kp, vp = jnp.pad(k, pad), jnp.pad(v, pad)
    slopes = alibi_slopes(N_HEADS).reshape(N_KV_HEADS, GQA_GROUP)
    sink_f = sink.astype(jnp.float32).reshape(N_KV_HEADS, GQA_GROUP)
    rel = jnp.arange(BAND)[None, :] - WINDOW - jnp.arange(BLOCK)[:, None]
    alibi = -slopes[:, :, None, None] * jnp.abs(rel).astype(jnp.float32)
    in_window = jnp.abs(rel) <= WINDOW
    starts = jnp.arange(S // BLOCK) * BLOCK

    def block(args):
        qi, start = args
        kb = lax.dynamic_slice_in_dim(kp, start, BAND, axis=1)
        vb = lax.dynamic_slice_in_dim(vp, start, BAND, axis=1)
        key_pos = start - WINDOW + jnp.arange(BAND)
        valid = in_window & ((key_pos >= 0) & (key_pos < S))[None, :]
        s = jnp.einsum('bqkgd,bskd->bkgqs', qi, kb).astype(jnp.float32) + alibi
        s = jnp.where(valid, s, NEG_INF)
        sink_col = jnp.broadcast_to(sink_f[:, :, None, None], s.shape[:-1] + (1,))
        p = jax.nn.softmax(jnp.concatenate([s, sink_col], axis=-1), axis=-1)[..., :-1]
        return jnp.einsum('bkgqs,bskd->bqkgd', p.astype(v.dtype), vb)

    o = from_blocks(lax.map(block, (to_blocks(q), starts)))
    return o.reshape(B, S, N_HEADS * HEAD_DIM) @ wo


def mixer_c(h, wqkv, lam_params, subln, wo, layer):
    B, S, _ = h.shape
    lam_init = _lambda_init(layer)
    q, k, v = project_qkv(h, wqkv, DIFF_HEADS, DIFF_KV_HEADS, 2 * HEAD_DIM, 2 * HEAD_DIM)
    q = (q * HEAD_DIM ** -0.5).reshape(B, S, DIFF_KV_HEADS, DIFF_GROUP, 2, HEAD_DIM)
    k = k.reshape(B, S, DIFF_KV_HEADS, 2, HEAD_DIM)
    lp = lam_params.astype(jnp.float32)
    lam = jnp.exp(jnp.sum(lp[0] * lp[1])) - jnp.exp(jnp.sum(lp[2] * lp[3])) + lam_init
    slopes = alibi_slopes(DIFF_HEADS).reshape(DIFF_KV_HEADS, DIFF_GROUP)
    key_pos = jnp.arange(S)
    starts = jnp.arange(S // BLOCK) * BLOCK

    def block(args):
        qi, start = args
        s = jnp.einsum('bqkgmd,bskmd->bkgmqs', qi, k).astype(jnp.float32)
        dist = jnp.abs(start + jnp.arange(BLOCK)[:, None] - key_pos[None, :]).astype(jnp.float32)
        s = s - slopes[:, :, None, None, None] * dist
        p = jax.nn.softmax(s, axis=-1)
        a = (p[:, :, :, 0] - lam * p[:, :, :, 1]).astype(v.dtype)
        return jnp.einsum('bkgqs,bskd->bqkgd', a, v)

    o = from_blocks(lax.map(block, (to_blocks(q), starts)))
    o = rms_norm(o, subln) * (1.0 - lam_init)
    return o.reshape(B, S, DIFF_HEADS * 2 * HEAD_DIM) @ wo


def mixer_d(h, wqkv, wo):
    B, S, _ = h.shape
    q, k, v = project_qkv(h, wqkv, N_HEADS, N_KV_HEADS, HEAD_DIM, HEAD_DIM)
    q = (q * HEAD_DIM ** -0.5).reshape(B, S, N_KV_HEADS, GQA_GROUP, HEAD_DIM)
    slopes = alibi_slopes(N_HEADS).reshape(N_KV_HEADS, GQA_GROUP)
    starts = jnp.arange(S // BLOCK) * BLOCK

    def block(args):
        qi, start = args
        t = start + jnp.arange(BLOCK)
        outs, lses = [], []
        for window, dil in DILATIONS:
            n_side = (window // 2) // dil
            off = dil * jnp.arange(-n_side, n_side + 1)
            idx = t[:, None] + off[None, :]
            valid = (idx >= 0) & (idx < S)
            idx = jnp.clip(idx, 0, S - 1)
            kg = jnp.take(k, idx, axis=1)
            vg = jnp.take(v, idx, axis=1)
            s = jnp.einsum('bqkgd,bqjkd->bkgqj', qi, kg).astype(jnp.float32)
            s = s - slopes[:, :, None, None] * jnp.abs(off).astype(jnp.float32)
            s = jnp.where(valid, s, NEG_INF)
            lse = jax.nn.logsumexp(s, axis=-1)
            p = jnp.exp(s - lse[..., None]).astype(v.dtype)
            outs.append(jnp.einsum('bkgqj,bqjkd->bqkgd', p, vg))
            lses.append(jnp.moveaxis(lse, -1, 1))
        wgt = jax.nn.softmax(jnp.stack(lses), axis=0).astype(v.dtype)
        return jnp.einsum('nbqkg,nbqkgd->bqkgd', wgt, jnp.stack(outs))

    o = from_blocks(lax.map(block, (to_blocks(q), starts)))
    return o.reshape(B, S, N_HEADS * HEAD_DIM) @ wo


def conv_glu(h, w_up, conv_w, conv_b, w_down):
    S = h.shape[1]
    u = h @ w_up
    a, b = u[..., :D_FF], u[..., D_FF:]
    half = CONV_WIDTH // 2
    ap = jnp.pad(a, ((0, 0), (half, half), (0, 0)))
    a = conv_b + sum(ap[:, j:j + S] * conv_w[j] for j in range(CONV_WIDTH))
    return (jax.nn.gelu(a, approximate=False) * b) @ w_down


def trunk(x, c, p):
    for i in range(DEPTH):
        mod = jax.nn.silu(c) @ p['w_ada'][i] + p['b_ada'][i]
        sh1, sc1, g1, sh2, sc2, g2 = jnp.split(mod[:, None, :], N_MOD, axis=-1)
        h = rms_norm(x, p['norm_attn'][i]) * (1.0 + sc1) + sh1
        m, j = i % N_MIXERS, i // N_MIXERS
        if m == 0:
            y = mixer_a(h, p['a_wqkv'][j], p['a_q_norm'][j], p['a_k_norm'][j], p['a_wo'][j])
        elif m == 1:
            y = mixer_b(h, p['b_wqkv'][j], p['b_sink'][j], p['b_wo'][j])
        elif m == 2:
            y = mixer_c(h, p['c_wqkv'][j], p['c_lambda'][j], p['c_subln'][j], p['c_wo'][j], i)
        else:
            y = mixer_d(h, p['d_wqkv'][j], p['d_wo'][j])
        x = x + g1 * y
        h = rms_norm(x, p['norm_ffn'][i]) * (1.0 + sc2) + sh2
        x = x + g2 * conv_glu(h, p['ffn_w_up'][i], p['ffn_conv_w'][i], p['ffn_conv_b'][i], p['ffn_w_down'][i])
    return rms_norm(x, p['norm_final'])


def _normal(key, shape, scale):
    return scale * jax.random.normal(key, shape, dtype=jnp.float32)


def setup_inputs(seed: int = 0) -> dict:
    key = jax.random.key(seed)
    ks = jax.random.split(key, 26)
    la, lb, lc, ld = (_n_uses(m) for m in range(N_MIXERS))
    D = D_MODEL
    inv = D ** -0.5
    attn_out = (N_HEADS * HEAD_DIM) ** -0.5
    return {
        'x_prompt': _normal(ks[0], (BATCH, SEQ, D), 1.0),
        'x_sample': _normal(ks[1], (DEC_BATCH, DEC_SEQ, D), 1.0),
        'c_prompt': _normal(ks[2], (BATCH, D), 1.0),
        'c_sample': _normal(ks[3], (DEC_BATCH, D), 1.0),
        'norm_attn': 1.0 + _normal(ks[4], (DEPTH, D), 0.05),
        'norm_ffn': 1.0 + _normal(ks[5], (DEPTH, D), 0.05),
        'w_ada': _normal(ks[6], (DEPTH, D, N_MOD * D), 0.5 * inv),
        'b_ada': _normal(ks[7], (DEPTH, N_MOD * D), 0.02),
        'a_wqkv': _normal(ks[8], (la, D, QKV_WIDTH), inv),
        'a_q_norm': 1.0 + _normal(ks[9], (la, HEAD_DIM), 0.05),
        'a_k_norm': 1.0 + _normal(ks[10], (la, HEAD_DIM), 0.05),
        'a_wo': _normal(ks[11], (la, N_HEADS * HEAD_DIM, D), attn_out),
        'b_wqkv': _normal(ks[12], (lb, D, QKV_WIDTH), inv),
        'b_sink': _normal(ks[13], (lb, N_HEADS), 0.5),
        'b_wo': _normal(ks[14], (lb, N_HEADS * HEAD_DIM, D), attn_out),
        'c_wqkv': _normal(ks[15], (lc, D, DIFF_QKV_WIDTH), inv),
        'c_lambda': _normal(ks[16], (lc, 4, HEAD_DIM), 0.1),
        'c_subln': 1.0 + _normal(ks[17], (lc, 2 * HEAD_DIM), 0.05),
        'c_wo': _normal(ks[18], (lc, DIFF_HEADS * 2 * HEAD_DIM, D), attn_out),
        'd_wqkv': _normal(ks[19], (ld, D, QKV_WIDTH), inv),
        'd_wo': _normal(ks[20], (ld, N_HEADS * HEAD_DIM, D), attn_out),
        'ffn_w_up': _normal(ks[21], (DEPTH, D, 2 * D_FF), inv),
        'ffn_conv_w': _normal(ks[22], (DEPTH, CONV_WIDTH, D_FF), CONV_WIDTH ** -0.5),
        'ffn_conv_b': _normal(ks[23], (DEPTH, D_FF), 0.02),
        'ffn_w_down': _normal(ks[24], (DEPTH, D_FF, D), D_FF ** -0.5),
        'norm_final': 1.0 + _normal(ks[25], (D,), 0.05),
    }


def reference(x_prompt, x_sample, c_prompt, c_sample, norm_attn, norm_ffn, w_ada, b_ada,
              a_wqkv, a_q_norm, a_k_norm, a_wo, b_wqkv, b_sink, b_wo,
              c_wqkv, c_lambda, c_subln, c_wo, d_wqkv, d_wo,
              ffn_w_up, ffn_conv_w, ffn_conv_b, ffn_w_down, norm_final):
    p = dict(norm_attn=norm_attn, norm_ffn=norm_ffn, w_ada=w_ada, b_ada=b_ada,
             a_wqkv=a_wqkv, a_q_norm=a_q_norm, a_k_norm=a_k_norm, a_wo=a_wo,
             b_wqkv=b_wqkv, b_sink=b_sink, b_wo=b_wo,
             c_wqkv=c_wqkv, c_lambda=c_lambda, c_subln=c_subln, c_wo=c_wo,
             d_wqkv=d_wqkv, d_wo=d_wo,
             ffn_w_up=ffn_w_up, ffn_conv_w=ffn_conv_w, ffn_conv_b=ffn_conv_b,
             ffn_w_down=ffn_w_down, norm_final=norm_final)
    y_prompt = trunk(x_prompt, c_prompt, p)
    y_sample = trunk(x_sample, c_sample, p)
    return (y_prompt, y_sample)
```

```cpp
#include <hip/hip_runtime.h>
#include <cstdio>
#include <cstdint>

#ifndef MK_MULTI
#define MK_MULTI 0
#endif
#ifndef NAIVE_ATTN
#define NAIVE_ATTN 1
#endif

#define LAS __attribute__((address_space(3)))
#define GAS __attribute__((address_space(1)))
typedef unsigned short bf16_t;
typedef short bf16x8 __attribute__((ext_vector_type(8)));
typedef float f32x4 __attribute__((ext_vector_type(4)));
typedef float f32x2 __attribute__((ext_vector_type(2)));
typedef unsigned u32x4 __attribute__((ext_vector_type(4)));
typedef unsigned u32x2 __attribute__((ext_vector_type(2)));

constexpr int DM = 2048, TOKP = 8192, TOKS = 32768, TOK = TOKP + TOKS, DFF = 5504, NB = 12;
constexpr int SP_ = 2048, SS_ = 4096;
constexpr float EPS = 1e-6f, LOG2E = 1.4426950408889634f;
constexpr float QSCALE = 0.08838834764831845f * LOG2E;
constexpr float LAM_INIT2 = 0.47071301834358826f;
constexpr int NWAVES = 8, NTHREADS = 512;

constexpr size_t MiB = 1u << 20;
constexpr size_t WS_CTL = 0, CTL_ZERO_BYTES = 1 * MiB;
constexpr size_t WS_MOD = 1 * MiB;
constexpr size_t WS_LSE = 4 * MiB;
constexpr size_t WS_WT = 8 * MiB;
constexpr size_t LWT = 92798976;
constexpr size_t WT_QKV = 0, WT_WO = 16 * MiB, WT_UP = 24 * MiB, WT_DOWN = 67 * MiB;
constexpr size_t WS_H = 364 * MiB;
constexpr size_t WS_BIG = 528 * MiB;
constexpr size_t WS_END = 960 * MiB;
static_assert(WS_WT + 4 * LWT <= WS_H && WS_H + (size_t)(TOK + 512) * DM * 2 <= WS_BIG && WS_BIG + (size_t)TOK * DFF * 2 <= WS_END, "ws map");
constexpr int CW_BAR = 4096;

constexpr int RING_BYTES = 131072, MISC_OFF = RING_BYTES + 320, LDS_BYTES = 147456;

__device__ __forceinline__ unsigned cvt_pk_bf16(float lo, float hi) { unsigned r; asm volatile("v_cvt_pk_bf16_f32 %0, %1, %2" : "=v"(r) : "v"(lo), "v"(hi)); return r; }
__device__ __forceinline__ float bf_lo(unsigned w) { return __uint_as_float(w << 16); }
__device__ __forceinline__ float bf_hi(unsigned w) { return __uint_as_float(w & 0xffff0000u); }
__device__ __forceinline__ float wave_sum(float v) {
#pragma unroll
    for (int o = 1; o < 64; o <<= 1) v += __shfl_xor(v, o);
    return v; }
__device__ __forceinline__ float wave_max(float v) {
#pragma unroll
    for (int o = 1; o < 64; o <<= 1) v = fmaxf(v, __shfl_xor(v, o));
    return v; }
__device__ __forceinline__ int seq_len_of(int T) { return T < TOKP ? SP_ : SS_; }
__device__ __forceinline__ int batch_of(int T) { return T < TOKP ? (T >> 11) : 4 + ((T - TOKP) >> 12); }

#define XB_TMO      128
#define XB_XCNT(j)  (256  + 64 * (j))
#define XB_XSUB(j)  (1280 + 64 * (j))
#define XB_XGEN(j)  (2304 + 64 * (j))
#define XB_TOP      3328
#define XB_TOPGEN   3392
#define XCD_BAR_WORDS 3456
#define XB_SPIN_CAP (1u << 22)
__device__ __forceinline__ unsigned xb_ld(unsigned* p)              { return __hip_atomic_load(p, __ATOMIC_RELAXED, __HIP_MEMORY_SCOPE_AGENT); }
__device__ __forceinline__ unsigned xb_add(unsigned* p, unsigned v) { return __hip_atomic_fetch_add(p, v, __ATOMIC_RELAXED, __HIP_MEMORY_SCOPE_AGENT); }
__device__ __forceinline__ unsigned xb_xcc_id() { return (unsigned)__builtin_amdgcn_s_getreg((3 << 11) | 20) & 0xFu; }
#define XB_SPIN(cond, bar) do { unsigned _sp = 0; while (cond) { __builtin_amdgcn_s_sleep(1); \
    if ((++_sp & 255u) == 0u) { if (xb_ld(&(bar)[XB_TMO])) break; if (_sp > XB_SPIN_CAP) { atomicAdd(&(bar)[XB_TMO], 1u); break; } } } } while (0)
struct XcdBarrier { unsigned* bar; unsigned x; volatile LAS unsigned* st; };
__device__ __forceinline__ XcdBarrier xcd_barrier_post(unsigned* bar, volatile LAS unsigned* st) {
    XcdBarrier b; b.bar = bar; b.x = xb_xcc_id(); b.st = st;
    if (threadIdx.x == 0) (void)xb_add(&bar[XB_XCNT(b.x)], 1u);
    return b;
}
__device__ __forceinline__ void xcd_barrier_complete(unsigned* bar, unsigned x, unsigned& nloc, unsigned& nx) {
    const unsigned G = gridDim.x * gridDim.y * gridDim.z;
    unsigned sum, cnt, mine, sp = 0u;
    for (;;) {
        sum = 0u; cnt = 0u; mine = 0u;
#pragma unroll
        for (unsigned j = 0; j < 16; ++j) { const unsigned c = xb_ld(&bar[XB_XCNT(j)]); sum += c; cnt += (c > 0u) ? 1u : 0u; mine = (j == x) ? c : mine; }
        if (sum == G) break;
        __builtin_amdgcn_s_sleep(1);
        if ((++sp & 255u) == 0u) { if (xb_ld(&bar[XB_TMO])) break; if (sp > XB_SPIN_CAP) { atomicAdd(&bar[XB_TMO], 1u); break; } }
    }
    nloc = mine > 0u ? mine : 1u; nx = cnt > 0u ? cnt : 1u;
}
__device__ __forceinline__ void xcd_barrier(const XcdBarrier& b) {
    asm volatile("s_waitcnt vmcnt(0)" ::: "memory");
    __syncthreads();
    if (threadIdx.x == 0) {
        unsigned* bar = b.bar;
        __builtin_amdgcn_s_waitcnt(0);
        unsigned nloc = b.st[0], nx = b.st[1];
        if (nloc == 0u) { xcd_barrier_complete(bar, b.x, nloc, nx); b.st[0] = nloc; b.st[1] = nx; }
        const unsigned old = xb_add(&bar[XB_XSUB(b.x)], 1u);
        const unsigned gen = old / nloc;
        if (old + 1u == (gen + 1u) * nloc) {
            __builtin_amdgcn_fence(__ATOMIC_RELEASE, "agent");
            asm volatile("s_waitcnt vmcnt(0)" ::: "memory");
            const unsigned og = xb_add(&bar[XB_TOP], 1u);
            const unsigned tg = og / nx;
            if (og + 1u == (tg + 1u) * nx) xb_add(&bar[XB_TOPGEN], 1u);
            else XB_SPIN(xb_ld(&bar[XB_TOPGEN]) == tg, bar);
            __builtin_amdgcn_fence(__ATOMIC_ACQUIRE, "agent");
            xb_add(&bar[XB_XGEN(b.x)], 1u);
            asm volatile("s_waitcnt vmcnt(0)" ::: "memory");
        } else {
            XB_SPIN(xb_ld(&bar[XB_XGEN(b.x)]) == gen, bar);
            __builtin_amdgcn_fence(__ATOMIC_ACQUIRE, "agent");
            asm volatile("s_waitcnt vmcnt(0)" ::: "memory");
        }
    }
    __syncthreads();
}

namespace pg8 {
constexpr int BM = 256, BK = 64, HALF = 128, HTB = HALF * BK * 2, STAGE_BYTES = 8 * HTB, NXCD = 8, WGM = 8;
__host__ __device__ __forceinline__ int lds_byte(int r, int c) { const int st = (r >> 4) * 2 + (c >> 5), rr = r & 15, cc = c & 31, ob = rr * 64 + cc * 2; return st * 1024 + (ob ^ (((ob >> 9) & 1) << 5)); }
__host__ __device__ __forceinline__ void stage_rc(int b, int& R, int& C) { const int st = b / 1024, sb = b % 1024, swz = sb ^ (((sb >> 9) & 1) << 5); R = (st >> 1) * 16 + swz / 64; C = (st & 1) * 32 + (swz % 64) / 2; }
__host__ __device__ __forceinline__ int perm32(int rho) { const int n = rho >> 4, i = rho & 15; return 8 * (i >> 2) + 4 * n + (i & 3); }
struct Unit { int pm, pn; };
struct Gemm { const bf16_t* A; const bf16_t* Bt; int K; };
struct StaticOrder {
    int nM, nN, nwg, G, c;
    __device__ void init(int nM_, int nN_, int G_, int c_) { nM = nM_; nN = nN_; nwg = nM * nN; G = G_; c = c_; }
    __device__ bool next(int i, Unit& u) const {
        const long L = (long)i * G + c; if (L >= nwg) return false;
        int wgid = (int)L; { const int q = nwg / NXCD, r = nwg % NXCD, xcd = wgid % NXCD, off = wgid / NXCD; wgid = (xcd < r ? xcd * (q + 1) : r * (q + 1) + (xcd - r) * q) + off; }
        const int nig = WGM * nN, gid = wgid / nig, fm = gid * WGM, gsz = (nM - fm) < WGM ? (nM - fm) : WGM;
        u.pm = fm + ((wgid % nig) % gsz); u.pn = (wgid % nig) / gsz; return true;
    }
};
template <class Epi, int AMODE>
__device__ __forceinline__ void gemm_phase(LAS unsigned char* lds, const Gemm g, const StaticOrder& S, const Epi& E) {
    int tid = threadIdx.x; asm volatile("" : "+v"(tid));
    const int wid = __builtin_amdgcn_readfirstlane(tid >> 6), lane = tid & 63, wr = wid >> 2, wc = wid & 3, fr = lane & 15, fq = lane >> 4;
    const int K = g.K, nt = K / BK;
    unsigned voffA[2], voffB[2];
#pragma unroll
    for (int i = 0; i < 2; ++i) { int R, C; stage_rc(tid * 16 + i * 8192, R, C); const int Rb = Epi::PERM ? ((R & ~31) + perm32(R & 31)) : R;
        const int Ra = AMODE == 1 ? (126 * (R >> 6) + (R & 63)) : R;
        voffA[i] = (unsigned)(Ra * K + C) * 2u; voffB[i] = (unsigned)(Rb * K + C) * 2u; }
    const size_t kstep = (size_t)(BK * 2);
    const size_t hstepB = (size_t)HALF * K * 2, tstepB = 2 * hstepB;
    const size_t hstepA = AMODE == 1 ? (size_t)64 * K * 2 : hstepB, tstepA = AMODE == 1 ? (size_t)252 * K * 2 : tstepB;
    const char* Abase = (const char*)g.A - (AMODE == 1 ? (size_t)K * 2 : 0);
    const unsigned ldsw = (unsigned)wid * 1024u;
    const int aoff = lds_byte(wr * 64 + fr, fq * 8), boff = lds_byte(wc * 32 + fr, fq * 8);
#define PG8_SA(b, h) (((b) * 2 + (h)) * HTB)
#define PG8_SB(b, h) ((4 + (b) * 2 + (h)) * HTB)
#define PG8_STAGE(bufoff, gbase, voff) do { _Pragma("unroll") for (int _i = 0; _i < 2; ++_i) \
        __builtin_amdgcn_global_load_lds((const unsigned*)((const char*)(gbase) + (voff)[_i]), (LAS unsigned*)(lds + (bufoff) + ldsw + _i * 8192), 16, 0, 0); } while (0)
#define PG8_LDA(dst, b, h) do { _Pragma("unroll") for (int m = 0; m < 4; ++m) _Pragma("unroll") for (int k = 0; k < 2; ++k) dst[m][k] = *(const LAS bf16x8*)(lds + PG8_SA(b, h) + aoff + m * 2048 + k * 1024); } while (0)
#define PG8_LDB(dst, b, h) do { _Pragma("unroll") for (int n = 0; n < 2; ++n) _Pragma("unroll") for (int k = 0; k < 2; ++k) dst[n][k] = *(const LAS bf16x8*)(lds + PG8_SB(b, h) + boff + n * 2048 + k * 1024); } while (0)
#define PG8_MMA(ai, bj, At, Bt) do { __builtin_amdgcn_s_setprio(1); _Pragma("unroll") for (int m = 0; m < 4; ++m) _Pragma("unroll") for (int n = 0; n < 2; ++n) _Pragma("unroll") for (int k = 0; k < 2; ++k) \
        acc[ai][bj][m][n] = __builtin_amdgcn_mfma_f32_16x16x32_bf16(Bt[n][k], At[m][k], acc[ai][bj][m][n], 0, 0, 0); __builtin_amdgcn_s_setprio(0); } while (0)
#define PG8_WAIT_V(n) asm volatile("s_waitcnt vmcnt(" #n ")" ::: "memory")
#define PG8_WAIT_L(n) asm volatile("s_waitcnt lgkmcnt(" #n ")" ::: "memory")
#define PG8_BAR __builtin_amdgcn_s_barrier()
#define PG8_SCHED __builtin_amdgcn_sched_barrier(0)
    Unit cur, nxt; int ui = 0;
    if (!S.next(0, cur)) return;
    f32x4 acc[2][2][4][2];
#pragma unroll
    for (int a = 0; a < 2; ++a)
#pragma unroll
        for (int b = 0; b < 2; ++b)
#pragma unroll
            for (int m = 0; m < 4; ++m)
#pragma unroll
                for (int n = 0; n < 2; ++n) acc[a][b][m][n] = (f32x4){0.f, 0.f, 0.f, 0.f};
    bf16x8 At[4][2], B0[2][2], B1[2][2];
    const char* cA = Abase + (size_t)cur.pm * tstepA; const char* cB = (const char*)g.Bt + (size_t)cur.pn * tstepB;
    PG8_STAGE(PG8_SB(0, 0), cB, voffB); PG8_STAGE(PG8_SB(0, 1), cB + hstepB, voffB); PG8_STAGE(PG8_SA(0, 0), cA, voffA); PG8_STAGE(PG8_SA(0, 1), cA + hstepA, voffA);
    if (wr == 1) PG8_BAR;
    PG8_WAIT_V(2); PG8_BAR;
    PG8_STAGE(PG8_SB(1, 0), cB + kstep, voffB); PG8_STAGE(PG8_SA(1, 0), cA + kstep, voffA); PG8_STAGE(PG8_SB(1, 1), cB + hstepB + kstep, voffB);
    PG8_WAIT_V(6); PG8_BAR;
    for (;;) {
        const bool has_next = S.next(ui + 1, nxt);
        const char* nA = has_next ? Abase + (size_t)nxt.pm * tstepA : cA; const char* nB = has_next ? (const char*)g.Bt + (size_t)nxt.pn * tstepB : cB;
        for (int t = 0; t < nt; t += 2) {
            const bool last = (t == nt - 2);
            const char* a1 = cA + (size_t)(t + 1) * kstep;
            const char* a2 = last ? nA : cA + (size_t)(t + 2) * kstep; const char* b2 = last ? nB : cB + (size_t)(t + 2) * kstep;
            const char* a3 = a2 + kstep; const char* b3 = b2 + kstep;
            PG8_LDB(B0, 0, 0); PG8_LDB(B1, 0, 1); PG8_SCHED; PG8_LDA(At, 0, 0); PG8_STAGE(PG8_SA(1, 1), a1 + hstepA, voffA);
            PG8_WAIT_V(8); PG8_WAIT_L(0); PG8_BAR; PG8_MMA(0, 0, At, B0); PG8_MMA(0, 1, At, B1); PG8_BAR; PG8_SCHED;
            PG8_LDA(At, 0, 1); PG8_STAGE(PG8_SB(0, 0), b2, voffB); PG8_STAGE(PG8_SB(0, 1), b2 + hstepB, voffB); PG8_STAGE(PG8_SA(0, 0), a2, voffA);
            PG8_WAIT_V(8); PG8_WAIT_L(0); PG8_BAR; PG8_MMA(1, 0, At, B0); PG8_MMA(1, 1, At, B1); PG8_BAR; PG8_SCHED;
            PG8_LDB(B0, 1, 0); PG8_LDB(B1, 1, 1); PG8_SCHED; PG8_LDA(At, 1, 0); PG8_STAGE(PG8_SA(0, 1), a2 + hstepA, voffA);
            PG8_WAIT_V(8); PG8_WAIT_L(0); PG8_BAR; PG8_MMA(0, 0, At, B0); PG8_MMA(0, 1, At, B1); PG8_BAR; PG8_SCHED;
            PG8_LDA(At, 1, 1); PG8_STAGE(PG8_SB(1, 0), b3, voffB); PG8_STAGE(PG8_SB(1, 1), b3 + hstepB, voffB); PG8_STAGE(PG8_SA(1, 0), a3, voffA);
            PG8_WAIT_V(8); PG8_WAIT_L(0); PG8_BAR; PG8_MMA(1, 0, At, B0); PG8_MMA(1, 1, At, B1); PG8_BAR; PG8_SCHED;
        }
        if (wr == 0) PG8_BAR;
        E(acc, cur, wr, wc, fr, fq);
        if (!has_next) break;
#pragma unroll
        for (int a = 0; a < 2; ++a)
#pragma unroll
            for (int b = 0; b < 2; ++b)
#pragma unroll
                for (int m = 0; m < 4; ++m)
#pragma unroll
                    for (int n = 0; n < 2; ++n) acc[a][b][m][n] = (f32x4){0.f, 0.f, 0.f, 0.f};
        cur = nxt; cA = nA; cB = nB; ++ui;
        if (wr == 1) PG8_BAR;
    }
    PG8_WAIT_V(0);
    PG8_BAR;
#undef PG8_SA
#undef PG8_SB
#undef PG8_STAGE
#undef PG8_LDA
#undef PG8_LDB
#undef PG8_MMA
#undef PG8_WAIT_V
#undef PG8_WAIT_L
#undef PG8_BAR
#undef PG8_SCHED
}

__device__ __forceinline__ f32x2 gelu_pk(f32x2 v) {
    const f32x2 av = __builtin_elementwise_abs(v), d = av * 0.2316418882f + 1.0f;
    f32x2 t; t.x = __builtin_amdgcn_rcpf(d.x); t.y = __builtin_amdgcn_rcpf(d.y);
    f32x2 q = t * 0.5307027145f + (-0.7265760135f); q = q * t + 0.7107068705f; q = q * t + (-0.142248368f); q = q * t + 0.127414796f; q = q * t;
    const f32x2 s = (v * v) * (-0.72134752044f);
    f32x2 e; e.x = __builtin_amdgcn_exp2f(s.x); e.y = __builtin_amdgcn_exp2f(s.y);
    const f32x2 m = v * (q * e), r = v - m;
    f32x2 o; o.x = v.x < 0.f ? m.x : r.x; o.y = v.y < 0.f ? m.y : r.y; return o;
}

struct EpiQKV {
    static constexpr bool PERM = true;
    bf16_t* O; int ldc; int qcols; float qscale;
    __device__ __forceinline__ void operator()(const f32x4 (&acc)[2][2][4][2], const Unit& u, int wr, int wc, int fr, int fq) const {
        const int row0 = u.pm * BM + wr * 64 + fr; const int col0 = u.pn * BM + wc * 32 + 8 * fq;
        const float sc = (u.pn * BM < qcols) ? qscale : 1.f;
#pragma unroll
        for (int ai = 0; ai < 2; ++ai)
#pragma unroll
            for (int m = 0; m < 4; ++m) { bf16_t* rowp = O + (size_t)(row0 + ai * HALF + m * 16) * ldc + col0;
#pragma unroll
                for (int bj = 0; bj < 2; ++bj) { const f32x4 v0 = acc[ai][bj][m][0] * sc, v1 = acc[ai][bj][m][1] * sc;
                    u32x4 w; w.x = cvt_pk_bf16(v0[0], v0[1]); w.y = cvt_pk_bf16(v0[2], v0[3]); w.z = cvt_pk_bf16(v1[0], v1[1]); w.w = cvt_pk_bf16(v1[2], v1[3]);
                    *(u32x4*)(rowp + bj * HALF) = w; } }
    }
};
struct EpiRes {
    static constexpr bool PERM = false;
    const float* base_p; const float* base_s;
    float* out; const float* gate;
    __device__ __forceinline__ void operator()(const f32x4 (&acc)[2][2][4][2], const Unit& u, int wr, int wc, int fr, int fq) const {
        const int row0 = u.pm * BM + wr * 64 + fr, col0 = u.pn * BM + wc * 32 + 4 * fq;
        const float* base = (u.pm * BM < TOKP) ? base_p : base_s;
        const float* gp = gate + (size_t)batch_of(u.pm * BM) * (6 * DM) + col0;
        f32x4 gv[2][2];
#pragma unroll
        for (int bj = 0; bj < 2; ++bj)
#pragma unroll
            for (int n = 0; n < 2; ++n) gv[bj][n] = *(const f32x4*)(gp + bj * HALF + n * 16);
#pragma unroll
        for (int ai = 0; ai < 2; ++ai)
#pragma unroll
            for (int m = 0; m < 4; ++m) { const size_t off = (size_t)(row0 + ai * HALF + m * 16) * DM + col0;
#pragma unroll
                for (int bj = 0; bj < 2; ++bj)
#pragma unroll
                    for (int n = 0; n < 2; ++n) { const f32x4 bs = *(const f32x4*)(base + off + bj * HALF + n * 16);
                        *(f32x4*)(out + off + bj * HALF + n * 16) = bs + gv[bj][n] * acc[ai][bj][m][n]; } }
    }
};
struct EpiGLU {
    static constexpr bool PERM = true;
    bf16_t* G; const float* cw; const float* cb;
    __device__ __forceinline__ void operator()(const f32x4 (&acc)[2][2][4][2], const Unit& u, int wr, int wc, int fr, int fq) const {
        const int lane = (fq << 4) | fr;
        const int f0 = 128 * u.pn + 32 * wc + 8 * fq;
        f32x4 w0[2], w1[2], w2[2], cbv[2];
#pragma unroll
        for (int n = 0; n < 2; ++n) { w0[n] = *(const f32x4*)(cw + f0 + 4 * n); w1[n] = *(const f32x4*)(cw + DFF + f0 + 4 * n); w2[n] = *(const f32x4*)(cw + 2 * DFF + f0 + 4 * n); cbv[n] = *(const f32x4*)(cb + f0 + 4 * n); }
        const int tok0 = 252 * u.pm + 126 * wr - 1;
        const int srcR = (lane & 48) | ((fr + 15) & 15), srcL = (lane & 48) | ((fr + 1) & 15);
        f32x4 rR_prev[2] = {(f32x4){0.f,0.f,0.f,0.f}, (f32x4){0.f,0.f,0.f,0.f}};
        f32x4 rL_cur[2], rL_nxt[2], rR_cur[2];
#pragma unroll
        for (int n = 0; n < 2; ++n)
#pragma unroll
            for (int e = 0; e < 4; ++e) rL_cur[n][e] = __shfl(acc[0][0][0][n][e], srcL);
#pragma unroll
        for (int am = 0; am < 8; ++am) {
            const int ai = am >> 2, m = am & 3;
#pragma unroll
            for (int n = 0; n < 2; ++n)
#pragma unroll
                for (int e = 0; e < 4; ++e) { rR_cur[n][e] = __shfl(acc[ai][0][m][n][e], srcR);
                    rL_nxt[n][e] = (am < 7) ? __shfl(acc[(am + 1) >> 2][0][(am + 1) & 3][n][e], srcL) : 0.f; }
            const int j = 16 * am + fr, tok = tok0 + j, S = seq_len_of(tok < 0 ? 0 : tok), tpos = tok & (S - 1);
            const bool first = (tpos == 0), lastt = (tpos == S - 1);
            const bool ok = (j >= 1) && (j <= 126) && (tok < TOK);
            u32x4 w;
#pragma unroll
            for (int n = 0; n < 2; ++n) {
                f32x4 pv, nv;
#pragma unroll
                for (int e = 0; e < 4; ++e) { pv[e] = (fr > 0) ? rR_cur[n][e] : rR_prev[n][e]; nv[e] = (fr < 15) ? rL_cur[n][e] : rL_nxt[n][e]; }
                if (first) pv = (f32x4){0.f, 0.f, 0.f, 0.f};
                if (lastt) nv = (f32x4){0.f, 0.f, 0.f, 0.f};
                const f32x4 v = cbv[n] + w0[n] * pv + w1[n] * acc[ai][0][m][n] + w2[n] * nv;
                const f32x2 g0 = gelu_pk((f32x2){v[0], v[1]}), g1 = gelu_pk((f32x2){v[2], v[3]});
                const f32x4 bb = acc[ai][1][m][n];
                const unsigned lo = cvt_pk_bf16(g0.x * bb[0], g0.y * bb[1]), hi = cvt_pk_bf16(g1.x * bb[2], g1.y * bb[3]);
                if (n == 0) { w.x = lo; w.y = hi; } else { w.z = lo; w.w = hi; }
            }
            if (ok) *(u32x4*)(G + (size_t)tok * DFF + f0) = w;
#pragma unroll
            for (int n = 0; n < 2; ++n) { rR_prev[n] = rR_cur[n]; rL_cur[n] = rL_nxt[n]; }
        }
    }
};
}

struct Args { const float* in[26]; float* out; unsigned char* ws; int ph_lo, ph_hi; };
struct Frame {
    LAS unsigned char* lds; int tid, lane, wave, vcu, G, gw, NGW;
    unsigned long long kargs; float* out; unsigned char* ws;
    bf16_t* hbuf; bf16_t* big; float* mod; float* lse;
};
__device__ __forceinline__ Frame fresh(const Frame& F0) { Frame F = F0;
    asm volatile("" : "+v"(F.tid), "+v"(F.lane), "+s"(F.wave), "+s"(F.vcu), "+s"(F.G), "+s"(F.gw), "+s"(F.NGW), "+s"(F.kargs));
    asm volatile("" : "+s"(F.out), "+s"(F.ws), "+s"(F.hbuf), "+s"(F.big), "+s"(F.mod), "+s"(F.lse)); return F; }
__device__ __forceinline__ const float* argp(const Frame& F, int idx) { unsigned long long p = F.kargs; asm volatile("" : "+s"(p)); return ((const float* const __attribute__((address_space(4)))*)p)[idx]; }
__device__ __forceinline__ bf16_t* wt_ptr(const Frame& F, int layer, size_t off) { return (bf16_t*)(F.ws + WS_WT + (size_t)layer * LWT + off); }

__device__ __forceinline__ void transpose_item(const float* W, int K, int N, bf16_t* WT, int dest_row0, int k0, int n0, LAS float* scr, int lane) {
#pragma unroll 8
    for (int i = 0; i < 32; ++i) { const int kk = 2 * i + (lane >> 5); scr[kk * 33 + (lane & 31)] = W[(size_t)(k0 + kk) * N + n0 + (lane & 31)]; }
    asm volatile("s_waitcnt lgkmcnt(0)" ::: "memory");
    const int c = lane & 7;
#pragma unroll
    for (int j = 0; j < 4; ++j) { const int n = (lane >> 3) + 8 * j; const LAS float* s = scr + (8 * c) * 33 + n;
        u32x4 o; o.x = cvt_pk_bf16(s[0 * 33], s[1 * 33]); o.y = cvt_pk_bf16(s[2 * 33], s[3 * 33]); o.z = cvt_pk_bf16(s[4 * 33], s[5 * 33]); o.w = cvt_pk_bf16(s[6 * 33], s[7 * 33]);
        *(u32x4*)(WT + (size_t)(dest_row0 + n) * K + k0 + 8 * c) = o; }
    asm volatile("s_waitcnt lgkmcnt(0)" ::: "memory");
}
__device__ __forceinline__ void phase_weights(const Frame& F0) {
    const Frame F = fresh(F0);
    LAS float* scr = (LAS float*)(F.lds + F.wave * 16384);
    for (int layer = 0; layer < 4; ++layer) {
        const int NQ = (layer == 2) ? 4096 : 3072;
        const float* wqkv = argp(F, layer == 0 ? 8 : layer == 1 ? 12 : layer == 2 ? 15 : 19);
        const float* wo = argp(F, layer == 0 ? 11 : layer == 1 ? 14 : layer == 2 ? 18 : 20);
        const float* wup = argp(F, 21) + (size_t)layer * DM * 2 * DFF;
        const float* wdn = argp(F, 24) + (size_t)layer * DFF * DM;
        const int I_Q = 32 * (NQ / 32), I_O = 32 * (DM / 32), I_U = 32 * (2 * DFF / 32), I_D = (DFF / 64) * (DM / 32);
        const int NIT = I_Q + I_O + I_U + I_D;
        for (int it = F.gw; it < NIT; it += F.NGW) {
            int r = it;
            if (r < I_Q) { const int nblk = NQ / 32, kb = r / nblk, nb = r % nblk; transpose_item(wqkv, DM, NQ, wt_ptr(F, layer, WT_QKV), 32 * nb, 64 * kb, 32 * nb, scr, F.lane); continue; } r -= I_Q;
            if (r < I_O) { const int nblk = DM / 32, kb = r / nblk, nb = r % nblk; transpose_item(wo, DM, DM, wt_ptr(F, layer, WT_WO), 32 * nb, 64 * kb, 32 * nb, scr, F.lane); continue; } r -= I_O;
            if (r < I_U) { const int nblk = 2 * DFF / 32, kb = r / nblk, nb = r % nblk; const int n0 = 32 * nb; const int half = n0 >= DFF ? 1 : 0, nn = n0 - half * DFF;
                const int drow = (nn >> 7) * 256 + half * 128 + (nn & 127);
                transpose_item(wup, DM, 2 * DFF, wt_ptr(F, layer, WT_UP), drow, 64 * kb, n0, scr, F.lane); continue; } r -= I_U;
            { const int nblk = DM / 32, kb = r / nblk, nb = r % nblk; transpose_item(wdn, DFF, DM, wt_ptr(F, layer, WT_DOWN), 32 * nb, 64 * kb, 32 * nb, scr, F.lane); }
        }
    }
}
__device__ __forceinline__ void phase_mod(const Frame& F0) {
    const Frame F = fresh(F0);
    LAS float* sl = (LAS float*)F.lds;
    LAS float* red = (LAS float*)(F.lds + 98304);
    for (int i = F.tid; i < NB * DM; i += NTHREADS) { const int b = i / DM, d = i % DM; const float c = b < 4 ? argp(F, 2)[b * DM + d] : argp(F, 3)[(b - 4) * DM + d];
        sl[d * NB + b] = c / (1.f + __expf(-c)); }
    __syncthreads();
    const int col = F.tid & 63, kg = F.tid >> 6;
    for (int unit = F.vcu; unit < 4 * 192; unit += F.G) {
        const int l = unit / 192, n0 = (unit % 192) * 64;
        const float* w = argp(F, 6) + (size_t)l * DM * (6 * DM) + n0 + col;
        float acc[NB];
#pragma unroll
        for (int b = 0; b < NB; ++b) acc[b] = 0.f;
        for (int d = kg * 256; d < kg * 256 + 256; ++d) { const float wv = w[(size_t)d * (6 * DM)];
            const f32x4 s0 = *(const LAS f32x4*)(sl + d * NB), s1 = *(const LAS f32x4*)(sl + d * NB + 4), s2 = *(const LAS f32x4*)(sl + d * NB + 8);
            acc[0] += wv * s0[0]; acc[1] += wv * s0[1]; acc[2] += wv * s0[2]; acc[3] += wv * s0[3];
            acc[4] += wv * s1[0]; acc[5] += wv * s1[1]; acc[6] += wv * s1[2]; acc[7] += wv * s1[3];
            acc[8] += wv * s2[0]; acc[9] += wv * s2[1]; acc[10] += wv * s2[2]; acc[11] += wv * s2[3]; }
#pragma unroll
        for (int b = 0; b < NB; ++b) red[(kg * NB + b) * 64 + col] = acc[b];
        __syncthreads();
        for (int o = F.tid; o < NB * 64; o += NTHREADS) { const int b = o >> 6, c2 = o & 63; float s = 0.f;
#pragma unroll
            for (int k = 0; k < 8; ++k) s += red[(k * NB + b) * 64 + c2];
            F.mod[((size_t)l * NB + b) * (6 * DM) + n0 + c2] = s + argp(F, 7)[(size_t)l * 6 * DM + n0 + c2]; }
        __syncthreads();
    }
}
__device__ __forceinline__ void phase_norm(const Frame& F0, const float* xp, const float* xs, const float* gain, const float* modl, int sh_chunk, int sc_chunk) {
    const Frame F = fresh(F0);
    for (int row = F.gw; row < TOK; row += F.NGW) {
        const float* xr = (row < TOKP ? xp : xs) + (size_t)row * DM;
        const float* mb = modl + (size_t)batch_of(row) * (6 * DM);
        f32x4 v[8]; float ss = 0.f;
#pragma unroll
        for (int j = 0; j < 8; ++j) { v[j] = *(const f32x4*)(xr + 4 * (F.lane + 64 * j)); ss += (v[j][0] * v[j][0] + v[j][1] * v[j][1]) + (v[j][2] * v[j][2] + v[j][3] * v[j][3]); }
        const float rstd = 1.0f / sqrtf(wave_sum(ss) * (1.f / DM) + EPS);
        bf16_t* orow = F.hbuf + (size_t)row * DM;
#pragma unroll
        for (int j = 0; j < 8; ++j) { const int c = 4 * (F.lane + 64 * j);
            const f32x4 g = *(const f32x4*)(gain + c), sc = *(const f32x4*)(mb + sc_chunk * DM + c), sh = *(const f32x4*)(mb + sh_chunk * DM + c);
            const f32x4 y = (v[j] * rstd) * g * (sc + 1.0f) + sh;
            u32x2 w; w.x = cvt_pk_bf16(y[0], y[1]); w.y = cvt_pk_bf16(y[2], y[3]); *(u32x2*)(orow + c) = w; }
    }
}
__device__ __forceinline__ void phase_final_norm(const Frame& F0, const float* gain) {
    const Frame F = fresh(F0);
    for (int row = F.gw; row < TOK; row += F.NGW) {
        float* xr = F.out + (size_t)row * DM;
        f32x4 v[8]; float ss = 0.f;
#pragma unroll
        for (int j = 0; j < 8; ++j) { v[j] = *(const f32x4*)(xr + 4 * (F.lane + 64 * j)); ss += (v[j][0] * v[j][0] + v[j][1] * v[j][1]) + (v[j][2] * v[j][2] + v[j][3] * v[j][3]); }
        const float rstd = 1.0f / sqrtf(wave_sum(ss) * (1.f / DM) + EPS);
#pragma unroll
        for (int j = 0; j < 8; ++j) { const int c = 4 * (F.lane + 64 * j); const f32x4 g = *(const f32x4*)(gain + c); *(f32x4*)(xr + c) = (v[j] * rstd) * g; }
    }
}
__device__ __forceinline__ void phase_qknorm_rope(const Frame& F0, const float* qn, const float* kn) {
    const Frame F = fresh(F0);
    const int k16 = F.lane & 15, grp = F.lane >> 4;
    for (int T = F.gw; T < TOK; T += F.NGW) {
        const int S = seq_len_of(T), t = T & (S - 1);
        const float posv = (k16 & 8) ? (float)(t & 63) : (float)(t >> 6);
        float cs[8], sn[8];
#pragma unroll
        for (int e = 0; e < 8; ++e) { const int f = 8 * (k16 & 3) + e; const float invf = exp2f(-(float)f * (13.287712379549449f / 32.f)); sincosf(posv * invf, &sn[e], &cs[e]); }
        const float sgn = (k16 & 4) ? 1.f : -1.f;
        bf16_t* rowp = F.big + (size_t)T * 3072;
        for (int it = 0; it < 5; ++it) {
            const int head = it * 4 + grp;
            bf16_t* p = rowp + head * 128 + 8 * k16;
            const u32x4 raw = *(const u32x4*)p;
            float x[8] = {bf_lo(raw.x), bf_hi(raw.x), bf_lo(raw.y), bf_hi(raw.y), bf_lo(raw.z), bf_hi(raw.z), bf_lo(raw.w), bf_hi(raw.w)};
            float ss = 0.f;
#pragma unroll
            for (int e = 0; e < 8; ++e) ss += x[e] * x[e];
            ss += __shfl_xor(ss, 1); ss += __shfl_xor(ss, 2); ss += __shfl_xor(ss, 4); ss += __shfl_xor(ss, 8);
            const float rstd = 1.0f / sqrtf(ss * (1.f / 128.f) + EPS);
            const float* gsrc = (head < 16 ? qn : kn) + 8 * k16;
            const float osc = head < 16 ? QSCALE : 1.f;
            float y[8], o[8];
#pragma unroll
            for (int e = 0; e < 8; ++e) y[e] = x[e] * rstd * gsrc[e];
#pragma unroll
            for (int e = 0; e < 8; ++e) { const float partner = __shfl_xor(y[e], 4); o[e] = (y[e] * cs[e] + sgn * partner * sn[e]) * osc; }
            u32x4 w; w.x = cvt_pk_bf16(o[0], o[1]); w.y = cvt_pk_bf16(o[2], o[3]); w.z = cvt_pk_bf16(o[4], o[5]); w.w = cvt_pk_bf16(o[6], o[7]);
            *(u32x4*)p = w;
        }
    }
}

__device__ __forceinline__ void q_to_lds(LAS float* qs, const bf16_t* q, int lane) { const unsigned w = *(const unsigned*)(q + 2 * lane); qs[2 * lane] = bf_lo(w); qs[2 * lane + 1] = bf_hi(w); }
__device__ __forceinline__ float qk_dot(const LAS float* qs, const bf16_t* krow) {
    float s = 0.f;
#pragma unroll
    for (int i = 0; i < 16; ++i) { const u32x4 kv = *(const u32x4*)(krow + 8 * i); const f32x4 qa = *(const LAS f32x4*)(qs + 8 * i), qb = *(const LAS f32x4*)(qs + 8 * i + 4);
        s += qa[0] * bf_lo(kv.x) + qa[1] * bf_hi(kv.x) + qa[2] * bf_lo(kv.y) + qa[3] * bf_hi(kv.y) + qb[0] * bf_lo(kv.z) + qb[1] * bf_hi(kv.z) + qb[2] * bf_lo(kv.w) + qb[3] * bf_hi(kv.w); }
    return s;
}
template <int NV> struct OSt { float m, l; float o[NV / 64]; };
template <int NV> __device__ __forceinline__ void attn_chunk(OSt<NV>& st, float s, int voff, const bf16_t* base, int lane) {
    const float cm = wave_max(s);
    if (cm == -INFINITY) return;
    const float mn = fmaxf(st.m, cm), alpha = __builtin_amdgcn_exp2f(st.m - mn), p = __builtin_amdgcn_exp2f(s - mn);
    st.l = st.l * alpha + wave_sum(p); st.m = mn;
#pragma unroll
    for (int k = 0; k < NV / 64; ++k) st.o[k] *= alpha;
    for (int jj = 0; jj < 64; ++jj) {
        const float pj = __uint_as_float(__builtin_amdgcn_readlane(__float_as_uint(p), jj));
        if (pj != 0.f) { const int off = __builtin_amdgcn_readlane(voff, jj);
            if (NV == 128) { const unsigned w = *(const unsigned*)(base + off + 2 * lane); st.o[0] += pj * bf_lo(w); st.o[1] += pj * bf_hi(w); }
            else { const u32x2 w = *(const u32x2*)(base + off + 4 * lane); st.o[0] += pj * bf_lo(w.x); st.o[1] += pj * bf_hi(w.x); st.o[2] += pj * bf_lo(w.y); st.o[3] += pj * bf_hi(w.y); } }
    }
}
template <int MIX> __device__ __forceinline__ void phase_attn_naive(const Frame& F0) {
    const Frame F = fresh(F0);
    LAS float* qs = (LAS float*)(F.lds + F.wave * 1024);
    const int NH = (MIX == 2) ? 8 : 16, W = (MIX == 2) ? 4096 : 3072;
    const bf16_t* qkv = F.big;
    for (int job = F.gw; job < TOK * NH; job += F.NGW) {
        const int T = job / NH, h = job % NH, S = seq_len_of(T), sb = T & ~(S - 1), t = T - sb;
        if (MIX != 2) {
            const int kvh = h >> 2, kcol = 2048 + kvh * 128, vcol = 2560 + kvh * 128;
            q_to_lds(qs, qkv + (size_t)T * W + h * 128, F.lane);
            asm volatile("s_waitcnt lgkmcnt(0)" ::: "memory");
            OSt<128> st; st.m = -1e30f; st.l = 0.f; st.o[0] = 0.f; st.o[1] = 0.f;
            const float slope2 = exp2f(-0.5f * (float)(h + 1)) * LOG2E;
            if (MIX == 0) {
                for (int c = 0; c < S / 64; ++c) { const int pos = 64 * c + F.lane; const int ro = (sb + pos) * W;
                    const float s = qk_dot(qs, qkv + ro + kcol); attn_chunk<128>(st, s, ro + vcol, qkv, F.lane); }
            } else if (MIX == 1) {
                st.m = argp(F, 13)[h] * LOG2E; st.l = 1.f;
                for (int c = 0; c < 5; ++c) { const int pos = t - 128 + 64 * c + F.lane; const int d = pos - t; const bool valid = (d >= -128) && (d <= 128) && (pos >= 0) && (pos < S);
                    const int pc = pos < 0 ? 0 : (pos > S - 1 ? S - 1 : pos); const int ro = (sb + pc) * W;
                    float s = qk_dot(qs, qkv + ro + kcol) - slope2 * fabsf((float)d); s = valid ? s : -INFINITY; attn_chunk<128>(st, s, ro + vcol, qkv, F.lane); }
            } else {
#pragma unroll
                for (int br = 0; br < 3; ++br) { const int dil = br == 0 ? 1 : br == 1 ? 4 : 16;
                    for (int c = 0; c < 3; ++c) { const int j = -64 + 64 * c + F.lane; const int pos = t + dil * j; const bool valid = (j <= 64) && (pos >= 0) && (pos < S);
                        const int pc = pos < 0 ? 0 : (pos > S - 1 ? S - 1 : pos); const int ro = (sb + pc) * W;
                        float s = qk_dot(qs, qkv + ro + kcol) - slope2 * (float)dil * fabsf((float)j); s = valid ? s : -INFINITY; attn_chunk<128>(st, s, ro + vcol, qkv, F.lane); } }
            }
            const float rl = 1.0f / st.l;
            *(unsigned*)(F.hbuf + (size_t)T * DM + h * 128 + 2 * F.lane) = cvt_pk_bf16(st.o[0] * rl, st.o[1] * rl);
        } else {
            const int kvh = h >> 1; const float slope2 = exp2f(-(float)(h + 1)) * LOG2E;
            const float* lp = argp(F, 16);
            const float d1 = wave_sum(lp[F.lane] * lp[128 + F.lane] + lp[64 + F.lane] * lp[192 + F.lane]);
            const float d2 = wave_sum(lp[256 + F.lane] * lp[384 + F.lane] + lp[320 + F.lane] * lp[448 + F.lane]);
            const float lam = expf(d1) - expf(d2) + LAM_INIT2;
            float om[2][4];
#pragma unroll
            for (int mp = 0; mp < 2; ++mp) {
                const int kcol = 2048 + kvh * 256 + mp * 128, vcol = 3072 + kvh * 256;
                q_to_lds(qs, qkv + (size_t)T * W + h * 256 + mp * 128, F.lane);
                asm volatile("s_waitcnt lgkmcnt(0)" ::: "memory");
                OSt<256> st; st.m = -1e30f; st.l = 0.f; st.o[0] = st.o[1] = st.o[2] = st.o[3] = 0.f;
                for (int c = 0; c < S / 64; ++c) { const int pos = 64 * c + F.lane; const int ro = (sb + pos) * W;
                    const float s = qk_dot(qs, qkv + ro + kcol) - slope2 * fabsf((float)(pos - t)); attn_chunk<256>(st, s, ro + vcol, qkv, F.lane); }
                const float rl = 1.0f / st.l;
#pragma unroll
                for (int k = 0; k < 4; ++k) om[mp][k] = st.o[k] * rl;
                asm volatile("s_waitcnt lgkmcnt(0)" ::: "memory");
            }
            float dd[4], ss = 0.f;
#pragma unroll
            for (int k = 0; k < 4; ++k) { dd[k] = om[0][k] - lam * om[1][k]; ss += dd[k] * dd[k]; }
            const float rstd = 1.0f / sqrtf(wave_sum(ss) * (1.f / 256.f) + EPS);
            const f32x4 sg = *(const f32x4*)(argp(F, 17) + 4 * F.lane);
            u32x2 w; w.x = cvt_pk_bf16(dd[0] * rstd * sg[0] * (1.f - LAM_INIT2), dd[1] * rstd * sg[1] * (1.f - LAM_INIT2));
            w.y = cvt_pk_bf16(dd[2] * rstd * sg[2] * (1.f - LAM_INIT2), dd[3] * rstd * sg[3] * (1.f - LAM_INIT2));
            *(u32x2*)(F.hbuf + (size_t)T * DM + h * 256 + 4 * F.lane) = w;
        }
    }
}

__global__ void __launch_bounds__(NTHREADS, 2) fwd(Args args) {
    extern __shared__ __attribute__((aligned(16))) unsigned char lds_raw[];
    Frame F;
    F.lds = (LAS unsigned char*)lds_raw;
    F.tid = threadIdx.x; F.lane = F.tid & 63; F.wave = __builtin_amdgcn_readfirstlane(F.tid >> 6);
    F.G = gridDim.x; { const int bx = blockIdx.x; F.vcu = (F.G % 8 == 0) ? (bx % 8) * (F.G / 8) + bx / 8 : bx; }
    F.gw = F.vcu * NWAVES + F.wave; F.NGW = F.G * NWAVES;
    F.kargs = (unsigned long long)__builtin_amdgcn_kernarg_segment_ptr(); F.out = args.out; F.ws = args.ws;
    F.hbuf = (bf16_t*)(args.ws + WS_H) + (size_t)256 * DM; F.big = (bf16_t*)(args.ws + WS_BIG); F.mod = (float*)(args.ws + WS_MOD); F.lse = (float*)(args.ws + WS_LSE);
    volatile LAS unsigned* MISC = (volatile LAS unsigned*)(F.lds + MISC_OFF);
    if (F.tid < 32) MISC[F.tid] = 0u;
    __syncthreads();
    unsigned* barw = (unsigned*)(args.ws + WS_CTL) + CW_BAR;
    XcdBarrier bar; bar.bar = barw; bar.x = 0; bar.st = nullptr;
    if (!MK_MULTI) bar = xcd_barrier_post(barw, MISC + 8);
    const int lo = args.ph_lo, hi = args.ph_hi;
#ifndef PHSEL
#define PHSEL(k) 1
#endif
#define IN(k) (PHSEL(k) && lo <= (k) && (k) < hi)
#define SEAM(k) do { if (!MK_MULTI) xcd_barrier(bar); } while (0)

    if (IN(0)) { phase_mod(F); __syncthreads(); phase_weights(F); SEAM(0); }

    for (int L0 = 0; L0 < 4; ++L0) {
        const int pb = 1 + 10 * L0;
#define LAYER_VARS() const Frame P = fresh(F); int L = L0; asm volatile("" : "+s"(L)); const float* modl = P.mod + (size_t)L * NB * 6 * DM; \
        const float* xin_p = (L == 0) ? argp(P, 0) : P.out; const float* xin_s = (L == 0) ? argp(P, 1) - (size_t)TOKP * DM : P.out; const int NQ = (L == 2) ? 4096 : 3072; (void)modl; (void)xin_p; (void)xin_s; (void)NQ
        if (IN(pb + 0)) { LAYER_VARS(); phase_norm(P, xin_p, xin_s, argp(P, 4) + L * DM, modl, 0, 1); SEAM(pb + 0); }
        if (IN(pb + 1)) { LAYER_VARS();
            pg8::Gemm g{P.hbuf, wt_ptr(P, L, WT_QKV), DM}; pg8::StaticOrder S; S.init(TOK / 256, NQ / 256, P.G, (int)blockIdx.x);
            pg8::EpiQKV E{P.big, NQ, 2048, (L == 0) ? 1.0f : QSCALE};
            pg8::gemm_phase<pg8::EpiQKV, 0>(P.lds, g, S, E);
            SEAM(pb + 1);
        }
        if (L0 == 0) {
            if (IN(pb + 2)) { phase_qknorm_rope(F, argp(F, 9), argp(F, 10)); SEAM(pb + 2); }
            if (IN(pb + 3)) { phase_attn_naive<0>(F); SEAM(pb + 3); }
        } else if (L0 == 1) {
            if (IN(pb + 2)) { phase_attn_naive<1>(F); SEAM(pb + 2); }
        } else if (L0 == 2) {
            if (IN(pb + 2)) { phase_attn_naive<2>(F); SEAM(pb + 2); }
        } else {
            if (IN(pb + 2)) { phase_attn_naive<3>(F); SEAM(pb + 2); }
        }
        if (IN(pb + 5)) { LAYER_VARS();
            pg8::Gemm g{P.hbuf, wt_ptr(P, L, WT_WO), DM}; pg8::StaticOrder S; S.init(TOK / 256, DM / 256, P.G, (int)blockIdx.x);
            pg8::EpiRes E{xin_p, xin_s, P.out, modl + 2 * DM};
            pg8::gemm_phase<pg8::EpiRes, 0>(P.lds, g, S, E);
            SEAM(pb + 5);
        }
        if (IN(pb + 6)) { LAYER_VARS(); phase_norm(P, P.out, P.out, argp(P, 5) + L * DM, modl, 3, 4); SEAM(pb + 6); }
        if (IN(pb + 7)) { LAYER_VARS();
            pg8::Gemm g{P.hbuf, wt_ptr(P, L, WT_UP), DM}; pg8::StaticOrder S; S.init(163, DFF / 128, P.G, (int)blockIdx.x);
            pg8::EpiGLU E{P.big, argp(P, 22) + (size_t)L * 3 * DFF, argp(P, 23) + (size_t)L * DFF};
            pg8::gemm_phase<pg8::EpiGLU, 1>(P.lds, g, S, E);
            SEAM(pb + 7);
        }
        if (IN(pb + 8)) { LAYER_VARS();
            pg8::Gemm g{P.big, wt_ptr(P, L, WT_DOWN), DFF}; pg8::StaticOrder S; S.init(TOK / 256, DM / 256, P.G, (int)blockIdx.x);
            pg8::EpiRes E{P.out, P.out, P.out, modl + 5 * DM};
            pg8::gemm_phase<pg8::EpiRes, 0>(P.lds, g, S, E);
            SEAM(pb + 8);
        }
#undef LAYER_VARS
    }
    if (IN(41)) phase_final_norm(F, argp(F, 25));
#undef IN
#undef SEAM
}

extern "C" void kernel_launch(void* const* d_in, const int* in_sizes, int n_in, void* d_out, int out_size, void* d_ws, size_t ws_size, hipStream_t stream) {
    static int grid = 0;
    if (grid == 0) {
        if (n_in != 26 || out_size != TOK * DM || ws_size < WS_END) { fprintf(stderr, "kernel_launch: unexpected shapes (n_in %d out %d ws %zu)\n", n_in, out_size, ws_size); grid = -1; return; }
        int dev = 0, cus = 0, per_cu = 0;
        if (hipGetDevice(&dev) != hipSuccess || hipDeviceGetAttribute(&cus, hipDeviceAttributeMultiprocessorCount, dev) != hipSuccess) { grid = -1; return; }
        if (hipFuncSetAttribute((const void*)fwd, hipFuncAttributeMaxDynamicSharedMemorySize, LDS_BYTES) != hipSuccess) { fprintf(stderr, "kernel_launch: hipFuncSetAttribute failed\n"); grid = -1; return; }
        if (hipOccupancyMaxActiveBlocksPerMultiprocessor(&per_cu, (const void*)fwd, NTHREADS, LDS_BYTES) != hipSuccess || per_cu < 1) fprintf(stderr, "kernel_launch: occupancy query says %d\n", per_cu);
        (void)hipGetLastError();
        grid = cus;
    }
    if (grid < 0) return;
    (void)hipMemsetAsync((char*)d_ws + WS_CTL, 0, CTL_ZERO_BYTES, stream);
    Args a{};
    for (int i = 0; i < 26; ++i) a.in[i] = (const float*)d_in[i];
    a.out = (float*)d_out; a.ws = (unsigned char*)d_ws;
#if MK_MULTI
    for (int p = 0; p < 42; ++p) {
        const int r = (p - 1) % 10, L = (p - 1) / 10;
        if (p >= 1 && p <= 40) { if (r == 9) continue; if (r == 4) continue; if (r == 3 && L != 0) continue; }
        a.ph_lo = p; a.ph_hi = p + 1;
        hipLaunchKernelGGL(fwd, dim3(grid), dim3(NTHREADS), LDS_BYTES, stream, a);
    }
#else
    a.ph_lo = 0; a.ph_hi = 42;
    hipLaunchKernelGGL(fwd, dim3(grid), dim3(NTHREADS), LDS_BYTES, stream, a);
#endif
}
```

```cpp
#include <hip/hip_runtime.h>
#include <cstdio>
#include <cstdint>

#ifndef MK_MULTI
#define MK_MULTI 0
#endif
#ifndef NAIVE_A
#define NAIVE_A 0
#endif
#ifndef NAIVE_B
#define NAIVE_B 0
#endif
#ifndef NAIVE_C
#define NAIVE_C 0
#endif
#ifndef NAIVE_D
#define NAIVE_D 0
#endif

#define LAS __attribute__((address_space(3)))
#define GAS __attribute__((address_space(1)))
#define LDG(T, p) (*(const GAS T*)(p))
#define STG(T, p) (*(GAS T*)(p))
typedef unsigned short bf16_t;
typedef short bf16x8 __attribute__((ext_vector_type(8)));
typedef float f32x4 __attribute__((ext_vector_type(4)));
typedef float f32x2 __attribute__((ext_vector_type(2)));
typedef unsigned u32x4 __attribute__((ext_vector_type(4)));
typedef unsigned u32x2 __attribute__((ext_vector_type(2)));

constexpr int DM = 2048, TOKP = 8192, TOKS = 32768, TOK = TOKP + TOKS, DFF = 5504, NB = 12;
constexpr int SP_ = 2048, SS_ = 4096;
constexpr float EPS = 1e-6f, LOG2E = 1.4426950408889634f;
constexpr float QSCALE = 0.08838834764831845f * LOG2E;
constexpr float LAM_INIT2 = 0.47071301834358826f;
constexpr int NWAVES = 8, NTHREADS = 512;

constexpr size_t MiB = 1u << 20;
constexpr size_t WS_CTL = 0, CTL_ZERO_BYTES = 1 * MiB;
constexpr size_t WS_MOD = 1 * MiB;
constexpr size_t WS_LSE = 4 * MiB;
constexpr size_t WS_WT = 8 * MiB;
constexpr size_t LWT = 92798976;
constexpr size_t WT_QKV = 0, WT_WO = 16 * MiB, WT_UP = 24 * MiB, WT_DOWN = 67 * MiB;
constexpr size_t WS_H = 364 * MiB;
constexpr size_t WS_BIG = 528 * MiB;
constexpr size_t WS_END = 960 * MiB;
static_assert(WS_WT + 4 * LWT <= WS_H && WS_H + (size_t)(TOK + 512) * DM * 2 <= WS_BIG && WS_BIG + (size_t)TOK * DFF * 2 <= WS_END, "ws map");
constexpr int CW_BAR = 4096;

constexpr int RING_BYTES = 131072, MISC_OFF = RING_BYTES + 320, LDS_BYTES = 147456;

__device__ __forceinline__ unsigned cvt_pk_bf16(float lo, float hi) { unsigned r; asm volatile("v_cvt_pk_bf16_f32 %0, %1, %2" : "=v"(r) : "v"(lo), "v"(hi)); return r; }
__device__ __forceinline__ float bf_lo(unsigned w) { return __uint_as_float(w << 16); }
__device__ __forceinline__ float bf_hi(unsigned w) { return __uint_as_float(w & 0xffff0000u); }
template <int O> __device__ __forceinline__ float swz_xor(float v) { return __int_as_float(__builtin_amdgcn_ds_swizzle(__float_as_int(v), (O << 10) | 0x1F)); }
__device__ __forceinline__ float wave_sum(float v) {
    v += swz_xor<1>(v); v += swz_xor<2>(v); v += swz_xor<4>(v); v += swz_xor<8>(v); v += swz_xor<16>(v);
    auto rr = __builtin_amdgcn_permlane32_swap(__float_as_uint(v), __float_as_uint(v), false, false); return __uint_as_float(rr[0]) + __uint_as_float(rr[1]); }
__device__ __forceinline__ float wave_max(float v) {
    v = fmaxf(v, swz_xor<1>(v)); v = fmaxf(v, swz_xor<2>(v)); v = fmaxf(v, swz_xor<4>(v)); v = fmaxf(v, swz_xor<8>(v)); v = fmaxf(v, swz_xor<16>(v));
    auto rr = __builtin_amdgcn_permlane32_swap(__float_as_uint(v), __float_as_uint(v), false, false); return fmaxf(__uint_as_float(rr[0]), __uint_as_float(rr[1])); }
__device__ __forceinline__ float bperm(float v, int src_byte) { return __int_as_float(__builtin_amdgcn_ds_bpermute(src_byte, __float_as_int(v))); }
__device__ __forceinline__ int seq_len_of(int T) { return T < TOKP ? SP_ : SS_; }
__device__ __forceinline__ int batch_of(int T) { return T < TOKP ? (T >> 11) : 4 + ((T - TOKP) >> 12); }

#define XB_TMO      128
#define XB_XCNT(j)  (256  + 64 * (j))
#define XB_XSUB(j)  (1280 + 64 * (j))
#define XB_XGEN(j)  (2304 + 64 * (j))
#define XB_TOP      3328
#define XB_TOPGEN   3392
#define XCD_BAR_WORDS 3456
#define XB_SPIN_CAP (1u << 22)
__device__ __forceinline__ unsigned xb_ld(unsigned* p)              { return __hip_atomic_load(p, __ATOMIC_RELAXED, __HIP_MEMORY_SCOPE_AGENT); }
__device__ __forceinline__ unsigned xb_add(unsigned* p, unsigned v) { return __hip_atomic_fetch_add(p, v, __ATOMIC_RELAXED, __HIP_MEMORY_SCOPE_AGENT); }
__device__ __forceinline__ unsigned xb_xcc_id() { return (unsigned)__builtin_amdgcn_s_getreg((3 << 11) | 20) & 0xFu; }
#define XB_SPIN(cond, bar) do { unsigned _sp = 0; while (cond) { __builtin_amdgcn_s_sleep(1); \
    if ((++_sp & 255u) == 0u) { if (xb_ld(&(bar)[XB_TMO])) break; if (_sp > XB_SPIN_CAP) { atomicAdd(&(bar)[XB_TMO], 1u); break; } } } } while (0)
struct XcdBarrier { unsigned* bar; unsigned x; volatile LAS unsigned* st; };
__device__ __forceinline__ XcdBarrier xcd_barrier_post(unsigned* bar, volatile LAS unsigned* st) {
    XcdBarrier b; b.bar = bar; b.x = xb_xcc_id(); b.st = st;
    if (threadIdx.x == 0) (void)xb_add(&bar[XB_XCNT(b.x)], 1u);
    return b;
}
__device__ __forceinline__ void xcd_barrier_complete(unsigned* bar, unsigned x, unsigned& nloc, unsigned& nx) {
    const unsigned G = gridDim.x * gridDim.y * gridDim.z;
    unsigned sum, cnt, mine, sp = 0u;
    for (;;) {
        sum = 0u; cnt = 0u; mine = 0u;
#pragma unroll
        for (unsigned j = 0; j < 16; ++j) { const unsigned c = xb_ld(&bar[XB_XCNT(j)]); sum += c; cnt += (c > 0u) ? 1u : 0u; mine = (j == x) ? c : mine; }
        if (sum == G) break;
        __builtin_amdgcn_s_sleep(1);
        if ((++sp & 255u) == 0u) { if (xb_ld(&bar[XB_TMO])) break; if (sp > XB_SPIN_CAP) { atomicAdd(&bar[XB_TMO], 1u); break; } }
    }
    nloc = mine > 0u ? mine : 1u; nx = cnt > 0u ? cnt : 1u;
}
__device__ __forceinline__ void xcd_barrier(const XcdBarrier& b) {
    asm volatile("s_waitcnt vmcnt(0)" ::: "memory");
    __syncthreads();
    if (threadIdx.x == 0) {
        unsigned* bar = b.bar;
        __builtin_amdgcn_s_waitcnt(0);
        unsigned nloc = b.st[0], nx = b.st[1];
        if (nloc == 0u) { xcd_barrier_complete(bar, b.x, nloc, nx); b.st[0] = nloc; b.st[1] = nx; }
        const unsigned old = xb_add(&bar[XB_XSUB(b.x)], 1u);
        const unsigned gen = old / nloc;
        if (old + 1u == (gen + 1u) * nloc) {
            __builtin_amdgcn_fence(__ATOMIC_RELEASE, "agent");
            asm volatile("s_waitcnt vmcnt(0)" ::: "memory");
            const unsigned og = xb_add(&bar[XB_TOP], 1u);
            const unsigned tg = og / nx;
            if (og + 1u == (tg + 1u) * nx) xb_add(&bar[XB_TOPGEN], 1u);
            else XB_SPIN(xb_ld(&bar[XB_TOPGEN]) == tg, bar);
            __builtin_amdgcn_fence(__ATOMIC_ACQUIRE, "agent");
            xb_add(&bar[XB_XGEN(b.x)], 1u);
            asm volatile("s_waitcnt vmcnt(0)" ::: "memory");
        } else {
            XB_SPIN(xb_ld(&bar[XB_XGEN(b.x)]) == gen, bar);
            __builtin_amdgcn_fence(__ATOMIC_ACQUIRE, "agent");
            asm volatile("s_waitcnt vmcnt(0)" ::: "memory");
        }
    }
    __syncthreads();
}

namespace pg8 {
constexpr int BM = 256, BK = 64, HALF = 128, HTB = HALF * BK * 2, STAGE_BYTES = 8 * HTB, NXCD = 8, WGM = 8;
__host__ __device__ __forceinline__ int lds_byte(int r, int c) { const int st = (r >> 4) * 2 + (c >> 5), rr = r & 15, cc = c & 31, ob = rr * 64 + cc * 2; return st * 1024 + (ob ^ (((ob >> 9) & 1) << 5)); }
__host__ __device__ __forceinline__ void stage_rc(int b, int& R, int& C) { const int st = b / 1024, sb = b % 1024, swz = sb ^ (((sb >> 9) & 1) << 5); R = (st >> 1) * 16 + swz / 64; C = (st & 1) * 32 + (swz % 64) / 2; }
__host__ __device__ __forceinline__ int perm32(int rho) { const int n = rho >> 4, i = rho & 15; return 8 * (i >> 2) + 4 * n + (i & 3); }
struct Unit { int pm, pn; };
struct Gemm { const bf16_t* A; const bf16_t* Bt; int K; };
struct StaticOrder {
    int nM, nN, nwg, G, c;
    __device__ void init(int nM_, int nN_, int G_, int c_) { nM = nM_; nN = nN_; nwg = nM * nN; G = G_; c = c_; }
    __device__ bool next(int i, Unit& u) const {
        const long L = (long)i * G + c; if (L >= nwg) return false;
        int wgid = (int)L; { const int q = nwg / NXCD, r = nwg % NXCD, xcd = wgid % NXCD, off = wgid / NXCD; wgid = (xcd < r ? xcd * (q + 1) : r * (q + 1) + (xcd - r) * q) + off; }
        const int nig = WGM * nN, gid = wgid / nig, fm = gid * WGM, gsz = (nM - fm) < WGM ? (nM - fm) : WGM;
        u.pm = fm + ((wgid % nig) % gsz); u.pn = (wgid % nig) / gsz; return true;
    }
};
template <class Epi, int AMODE>
__device__ __forceinline__ void gemm_phase(LAS unsigned char* lds, const Gemm g, const StaticOrder& S, const Epi& E) {
    int tid = threadIdx.x; asm volatile("" : "+v"(tid));
    const int wid = __builtin_amdgcn_readfirstlane(tid >> 6), lane = tid & 63, wr = wid >> 2, wc = wid & 3, fr = lane & 15, fq = lane >> 4;
    const int K = g.K, nt = K / BK;
    unsigned voffA[2], voffB[2];
#pragma unroll
    for (int i = 0; i < 2; ++i) { int R, C; stage_rc(tid * 16 + i * 8192, R, C); const int Rb = Epi::PERM ? ((R & ~31) + perm32(R & 31)) : R;
        const int Ra = AMODE == 1 ? (126 * (R >> 6) + (R & 63)) : R;
        voffA[i] = (unsigned)(Ra * K + C) * 2u; voffB[i] = (unsigned)(Rb * K + C) * 2u; }
    const size_t kstep = (size_t)(BK * 2);
    const size_t hstepB = (size_t)HALF * K * 2, tstepB = 2 * hstepB;
    const size_t hstepA = AMODE == 1 ? (size_t)64 * K * 2 : hstepB, tstepA = AMODE == 1 ? (size_t)252 * K * 2 : tstepB;
    const char* Abase = (const char*)g.A - (AMODE == 1 ? (size_t)K * 2 : 0);
    const unsigned ldsw = (unsigned)wid * 1024u;
    const int aoff = lds_byte(wr * 64 + fr, fq * 8), boff = lds_byte(wc * 32 + fr, fq * 8);
#define PG8_SA(b, h) (((b) * 2 + (h)) * HTB)
#define PG8_SB(b, h) ((4 + (b) * 2 + (h)) * HTB)
#define PG8_STAGE(bufoff, gbase, voff) do { _Pragma("unroll") for (int _i = 0; _i < 2; ++_i) \
        __builtin_amdgcn_global_load_lds((const unsigned*)((const char*)(gbase) + (voff)[_i]), (LAS unsigned*)(lds + (bufoff) + ldsw + _i * 8192), 16, 0, 0); } while (0)
#define PG8_LDA(dst, b, h) do { _Pragma("unroll") for (int m = 0; m < 4; ++m) _Pragma("unroll") for (int k = 0; k < 2; ++k) dst[m][k] = *(const LAS bf16x8*)(lds + PG8_SA(b, h) + aoff + m * 2048 + k * 1024); } while (0)
#define PG8_LDB(dst, b, h) do { _Pragma("unroll") for (int n = 0; n < 2; ++n) _Pragma("unroll") for (int k = 0; k < 2; ++k) dst[n][k] = *(const LAS bf16x8*)(lds + PG8_SB(b, h) + boff + n * 2048 + k * 1024); } while (0)
#define PG8_MMA(ai, bj, At, Bt) do { __builtin_amdgcn_s_setprio(1); _Pragma("unroll") for (int m = 0; m < 4; ++m) _Pragma("unroll") for (int n = 0; n < 2; ++n) _Pragma("unroll") for (int k = 0; k < 2; ++k) \
        acc[ai][bj][m][n] = __builtin_amdgcn_mfma_f32_16x16x32_bf16(Bt[n][k], At[m][k], acc[ai][bj][m][n], 0, 0, 0); __builtin_amdgcn_s_setprio(0); } while (0)
#define PG8_WAIT_V(n) asm volatile("s_waitcnt vmcnt(" #n ")" ::: "memory")
#define PG8_WAIT_L(n) asm volatile("s_waitcnt lgkmcnt(" #n ")" ::: "memory")
#define PG8_BAR __builtin_amdgcn_s_barrier()
#define PG8_SCHED __builtin_amdgcn_sched_barrier(0)
    Unit cur, nxt; int ui = 0;
    if (!S.next(0, cur)) return;
    f32x4 acc[2][2][4][2];
#pragma unroll
    for (int a = 0; a < 2; ++a)
#pragma unroll
        for (int b = 0; b < 2; ++b)
#pragma unroll
            for (int m = 0; m < 4; ++m)
#pragma unroll
                for (int n = 0; n < 2; ++n) acc[a][b][m][n] = (f32x4){0.f, 0.f, 0.f, 0.f};
    bf16x8 At[4][2], B0[2][2], B1[2][2];
    const char* cA = Abase + (size_t)cur.pm * tstepA; const char* cB = (const char*)g.Bt + (size_t)cur.pn * tstepB;
    PG8_STAGE(PG8_SB(0, 0), cB, voffB); PG8_STAGE(PG8_SB(0, 1), cB + hstepB, voffB); PG8_STAGE(PG8_SA(0, 0), cA, voffA); PG8_STAGE(PG8_SA(0, 1), cA + hstepA, voffA);
    if (wr == 1) PG8_BAR;
    PG8_WAIT_V(2); PG8_BAR;
    PG8_STAGE(PG8_SB(1, 0), cB + kstep, voffB); PG8_STAGE(PG8_SA(1, 0), cA + kstep, voffA); PG8_STAGE(PG8_SB(1, 1), cB + hstepB + kstep, voffB);
    PG8_WAIT_V(6); PG8_BAR;
    for (;;) {
        const bool has_next = S.next(ui + 1, nxt);
        const char* nA = has_next ? Abase + (size_t)nxt.pm * tstepA : cA; const char* nB = has_next ? (const char*)g.Bt + (size_t)nxt.pn * tstepB : cB;
        for (int t = 0; t < nt; t += 2) {
            const bool last = (t == nt - 2);
            const char* a1 = cA + (size_t)(t + 1) * kstep;
            const char* a2 = last ? nA : cA + (size_t)(t + 2) * kstep; const char* b2 = last ? nB : cB + (size_t)(t + 2) * kstep;
            const char* a3 = a2 + kstep; const char* b3 = b2 + kstep;
            PG8_LDB(B0, 0, 0); PG8_LDB(B1, 0, 1); PG8_SCHED; PG8_LDA(At, 0, 0); PG8_STAGE(PG8_SA(1, 1), a1 + hstepA, voffA);
            PG8_WAIT_V(8); PG8_WAIT_L(0); PG8_BAR; PG8_MMA(0, 0, At, B0); PG8_MMA(0, 1, At, B1); PG8_BAR; PG8_SCHED;
            PG8_LDA(At, 0, 1); PG8_STAGE(PG8_SB(0, 0), b2, voffB); PG8_STAGE(PG8_SB(0, 1), b2 + hstepB, voffB); PG8_STAGE(PG8_SA(0, 0), a2, voffA);
            PG8_WAIT_V(8); PG8_WAIT_L(0); PG8_BAR; PG8_MMA(1, 0, At, B0); PG8_MMA(1, 1, At, B1); PG8_BAR; PG8_SCHED;
            PG8_LDB(B0, 1, 0); PG8_LDB(B1, 1, 1); PG8_SCHED; PG8_LDA(At, 1, 0); PG8_STAGE(PG8_SA(0, 1), a2 + hstepA, voffA);
            PG8_WAIT_V(8); PG8_WAIT_L(0); PG8_BAR; PG8_MMA(0, 0, At, B0); PG8_MMA(0, 1, At, B1); PG8_BAR; PG8_SCHED;
            PG8_LDA(At, 1, 1); PG8_STAGE(PG8_SB(1, 0), b3, voffB); PG8_STAGE(PG8_SB(1, 1), b3 + hstepB, voffB); PG8_STAGE(PG8_SA(1, 0), a3, voffA);
            PG8_WAIT_V(8); PG8_WAIT_L(0); PG8_BAR; PG8_MMA(1, 0, At, B0); PG8_MMA(1, 1, At, B1); PG8_BAR; PG8_SCHED;
        }
        if (wr == 0) PG8_BAR;
        E(acc, cur, wr, wc, fr, fq);
        if (!has_next) break;
#pragma unroll
        for (int a = 0; a < 2; ++a)
#pragma unroll
            for (int b = 0; b < 2; ++b)
#pragma unroll
                for (int m = 0; m < 4; ++m)
#pragma unroll
                    for (int n = 0; n < 2; ++n) acc[a][b][m][n] = (f32x4){0.f, 0.f, 0.f, 0.f};
        cur = nxt; cA = nA; cB = nB; ++ui;
        if (wr == 1) PG8_BAR;
    }
    PG8_WAIT_V(0);
    PG8_BAR;
#undef PG8_SA
#undef PG8_SB
#undef PG8_STAGE
#undef PG8_LDA
#undef PG8_LDB
#undef PG8_MMA
#undef PG8_WAIT_V
#undef PG8_WAIT_L
#undef PG8_BAR
#undef PG8_SCHED
}

__device__ __forceinline__ f32x2 gelu_pk(f32x2 v) {
    const f32x2 av = __builtin_elementwise_abs(v), d = av * 0.2316418882f + 1.0f;
    f32x2 t; t.x = __builtin_amdgcn_rcpf(d.x); t.y = __builtin_amdgcn_rcpf(d.y);
    f32x2 q = t * 0.5307027145f + (-0.7265760135f); q = q * t + 0.7107068705f; q = q * t + (-0.142248368f); q = q * t + 0.127414796f; q = q * t;
    const f32x2 s = (v * v) * (-0.72134752044f);
    f32x2 e; e.x = __builtin_amdgcn_exp2f(s.x); e.y = __builtin_amdgcn_exp2f(s.y);
    const f32x2 m = v * (q * e), r = v - m;
    f32x2 o; o.x = v.x < 0.f ? m.x : r.x; o.y = v.y < 0.f ? m.y : r.y; return o;
}

struct EpiQKV {
    static constexpr bool PERM = true;
    bf16_t* O; int ldc; int qcols; float qscale;
    __device__ __forceinline__ void operator()(const f32x4 (&acc)[2][2][4][2], const Unit& u, int wr, int wc, int fr, int fq) const {
        const int row0 = u.pm * BM + wr * 64 + fr; const int col0 = u.pn * BM + wc * 32 + 8 * fq;
        const float sc = (u.pn * BM < qcols) ? qscale : 1.f;
#pragma unroll
        for (int ai = 0; ai < 2; ++ai)
#pragma unroll
            for (int m = 0; m < 4; ++m) { bf16_t* rowp = O + (size_t)(row0 + ai * HALF + m * 16) * ldc + col0;
#pragma unroll
                for (int bj = 0; bj < 2; ++bj) { const f32x4 v0 = acc[ai][bj][m][0] * sc, v1 = acc[ai][bj][m][1] * sc;
                    u32x4 w; w.x = cvt_pk_bf16(v0[0], v0[1]); w.y = cvt_pk_bf16(v0[2], v0[3]); w.z = cvt_pk_bf16(v1[0], v1[1]); w.w = cvt_pk_bf16(v1[2], v1[3]);
                    STG(u32x4, rowp + bj * HALF) = w; } }
    }
};
struct EpiRes {
    static constexpr bool PERM = false;
    const float* base_p; const float* base_s;
    float* out; const float* gate;
    __device__ __forceinline__ void operator()(const f32x4 (&acc)[2][2][4][2], const Unit& u, int wr, int wc, int fr, int fq) const {
        const int row0 = u.pm * BM + wr * 64 + fr, col0 = u.pn * BM + wc * 32 + 4 * fq;
        const float* base = (u.pm * BM < TOKP) ? base_p : base_s;
        const float* gp = gate + (size_t)batch_of(u.pm * BM) * (6 * DM) + col0;
        f32x4 gv[2][2];
#pragma unroll
        for (int bj = 0; bj < 2; ++bj)
#pragma unroll
            for (int n = 0; n < 2; ++n) gv[bj][n] = LDG(f32x4, gp + bj * HALF + n * 16);
#pragma unroll
        for (int ai = 0; ai < 2; ++ai)
#pragma unroll
            for (int m = 0; m < 4; ++m) { const size_t off = (size_t)(row0 + ai * HALF + m * 16) * DM + col0;
#pragma unroll
                for (int bj = 0; bj < 2; ++bj)
#pragma unroll
                    for (int n = 0; n < 2; ++n) { const f32x4 bs = LDG(f32x4, base + off + bj * HALF + n * 16);
                        STG(f32x4, out + off + bj * HALF + n * 16) = bs + gv[bj][n] * acc[ai][bj][m][n]; } }
    }
};
struct EpiGLU {
    static constexpr bool PERM = true;
    bf16_t* G; const float* cw; const float* cb;
    __device__ __forceinline__ void operator()(const f32x4 (&acc)[2][2][4][2], const Unit& u, int wr, int wc, int fr, int fq) const {
        const int lane = (fq << 4) | fr;
        const int f0 = 128 * u.pn + 32 * wc + 8 * fq;
        f32x4 w0[2], w1[2], w2[2], cbv[2];
#pragma unroll
        for (int n = 0; n < 2; ++n) { w0[n] = LDG(f32x4, cw + f0 + 4 * n); w1[n] = LDG(f32x4, cw + DFF + f0 + 4 * n); w2[n] = LDG(f32x4, cw + 2 * DFF + f0 + 4 * n); cbv[n] = LDG(f32x4, cb + f0 + 4 * n); }
        const int tok0 = 252 * u.pm + 126 * wr - 1;
        const int srcR = ((lane & 48) | ((fr + 15) & 15)) << 2, srcL = ((lane & 48) | ((fr + 1) & 15)) << 2;
        f32x4 rR_prev[2] = {(f32x4){0.f,0.f,0.f,0.f}, (f32x4){0.f,0.f,0.f,0.f}};
        f32x4 rL_cur[2], rL_nxt[2], rR_cur[2];
#pragma unroll
        for (int n = 0; n < 2; ++n)
#pragma unroll
            for (int e = 0; e < 4; ++e) rL_cur[n][e] = bperm(acc[0][0][0][n][e], srcL);
#pragma unroll
        for (int am = 0; am < 8; ++am) {
            const int ai = am >> 2, m = am & 3;
#pragma unroll
            for (int n = 0; n < 2; ++n)
#pragma unroll
                for (int e = 0; e < 4; ++e) { rR_cur[n][e] = bperm(acc[ai][0][m][n][e], srcR);
                    rL_nxt[n][e] = (am < 7) ? bperm(acc[(am + 1) >> 2][0][(am + 1) & 3][n][e], srcL) : 0.f; }
            const int j = 16 * am + fr, tok = tok0 + j, S = seq_len_of(tok < 0 ? 0 : tok), tpos = tok & (S - 1);
            const bool first = (tpos == 0), lastt = (tpos == S - 1);
            const bool ok = (j >= 1) && (j <= 126) && (tok < TOK);
            u32x4 w;
#pragma unroll
            for (int n = 0; n < 2; ++n) {
                f32x4 pv, nv;
#pragma unroll
                for (int e = 0; e < 4; ++e) { pv[e] = (fr > 0) ? rR_cur[n][e] : rR_prev[n][e]; nv[e] = (fr < 15) ? rL_cur[n][e] : rL_nxt[n][e]; }
                if (first) pv = (f32x4){0.f, 0.f, 0.f, 0.f};
                if (lastt) nv = (f32x4){0.f, 0.f, 0.f, 0.f};
                const f32x4 v = cbv[n] + w0[n] * pv + w1[n] * acc[ai][0][m][n] + w2[n] * nv;
                const f32x2 g0 = gelu_pk((f32x2){v[0], v[1]}), g1 = gelu_pk((f32x2){v[2], v[3]});
                const f32x4 bb = acc[ai][1][m][n];
                const unsigned lo = cvt_pk_bf16(g0.x * bb[0], g0.y * bb[1]), hi = cvt_pk_bf16(g1.x * bb[2], g1.y * bb[3]);
                if (n == 0) { w.x = lo; w.y = hi; } else { w.z = lo; w.w = hi; }
            }
            if (ok) STG(u32x4, G + (size_t)tok * DFF + f0) = w;
#pragma unroll
            for (int n = 0; n < 2; ++n) { rR_prev[n] = rR_cur[n]; rL_cur[n] = rL_nxt[n]; }
        }
    }
};
}

struct Args { const float* in[26]; float* out; unsigned char* ws; int ph_lo, ph_hi; };
struct Frame {
    LAS unsigned char* lds; int tid, lane, wave, vcu, G, gw, NGW;
    unsigned long long kargs; float* out; unsigned char* ws;
    bf16_t* hbuf; bf16_t* big; float* mod; float* lse;
};
__device__ __forceinline__ Frame fresh(const Frame& F0) { Frame F = F0;
    asm volatile("" : "+v"(F.tid), "+v"(F.lane), "+s"(F.wave), "+s"(F.vcu), "+s"(F.G), "+s"(F.gw), "+s"(F.NGW), "+s"(F.kargs));
    asm volatile("" : "+s"(F.out), "+s"(F.ws), "+s"(F.hbuf), "+s"(F.big), "+s"(F.mod), "+s"(F.lse)); return F; }
__device__ __forceinline__ const float* argp(const Frame& F, int idx) { unsigned long long p = F.kargs; asm volatile("" : "+s"(p)); return ((const float* const __attribute__((address_space(4)))*)p)[idx]; }
__device__ __forceinline__ bf16_t* wt_ptr(const Frame& F, int layer, size_t off) { return (bf16_t*)(F.ws + WS_WT + (size_t)layer * LWT + off); }

__device__ __forceinline__ void transpose_item(const float* W, int K, int N, bf16_t* WT, int dest_row0, int k0, int n0, LAS float* scr, int lane) {
#pragma unroll 8
    for (int i = 0; i < 32; ++i) { const int kk = 2 * i + (lane >> 5); scr[kk * 33 + (lane & 31)] = LDG(float, W + (size_t)(k0 + kk) * N + n0 + (lane & 31)); }
    asm volatile("s_waitcnt lgkmcnt(0)" ::: "memory");
    const int c = lane & 7;
#pragma unroll
    for (int j = 0; j < 4; ++j) { const int n = (lane >> 3) + 8 * j; const LAS float* s = scr + (8 * c) * 33 + n;
        u32x4 o; o.x = cvt_pk_bf16(s[0 * 33], s[1 * 33]); o.y = cvt_pk_bf16(s[2 * 33], s[3 * 33]); o.z = cvt_pk_bf16(s[4 * 33], s[5 * 33]); o.w = cvt_pk_bf16(s[6 * 33], s[7 * 33]);
        STG(u32x4, WT + (size_t)(dest_row0 + n) * K + k0 + 8 * c) = o; }
    asm volatile("s_waitcnt lgkmcnt(0)" ::: "memory");
}
__device__ __forceinline__ void phase_weights(const Frame& F0) {
    const Frame F = fresh(F0);
    LAS float* scr = (LAS float*)(F.lds + F.wave * 16384);
    for (int layer = 0; layer < 4; ++layer) {
        const int NQ = (layer == 2) ? 4096 : 3072;
        const float* wqkv = argp(F, layer == 0 ? 8 : layer == 1 ? 12 : layer == 2 ? 15 : 19);
        const float* wo = argp(F, layer == 0 ? 11 : layer == 1 ? 14 : layer == 2 ? 18 : 20);
        const float* wup = argp(F, 21) + (size_t)layer * DM * 2 * DFF;
        const float* wdn = argp(F, 24) + (size_t)layer * DFF * DM;
        const int I_Q = 32 * (NQ / 32), I_O = 32 * (DM / 32), I_U = 32 * (2 * DFF / 32), I_D = (DFF / 64) * (DM / 32);
        const int NIT = I_Q + I_O + I_U + I_D;
        for (int it = F.gw; it < NIT; it += F.NGW) {
            int r = it;
            if (r < I_Q) { const int nblk = NQ / 32, kb = r / nblk, nb = r % nblk; transpose_item(wqkv, DM, NQ, wt_ptr(F, layer, WT_QKV), 32 * nb, 64 * kb, 32 * nb, scr, F.lane); continue; } r -= I_Q;
            if (r < I_O) { const int nblk = DM / 32, kb = r / nblk, nb = r % nblk; transpose_item(wo, DM, DM, wt_ptr(F, layer, WT_WO), 32 * nb, 64 * kb, 32 * nb, scr, F.lane); continue; } r -= I_O;
            if (r < I_U) { const int nblk = 2 * DFF / 32, kb = r / nblk, nb = r % nblk; const int n0 = 32 * nb; const int half = n0 >= DFF ? 1 : 0, nn = n0 - half * DFF;
                const int drow = (nn >> 7) * 256 + half * 128 + (nn & 127);
                transpose_item(wup, DM, 2 * DFF, wt_ptr(F, layer, WT_UP), drow, 64 * kb, n0, scr, F.lane); continue; } r -= I_U;
            { const int nblk = DM / 32, kb = r / nblk, nb = r % nblk; transpose_item(wdn, DFF, DM, wt_ptr(F, layer, WT_DOWN), 32 * nb, 64 * kb, 32 * nb, scr, F.lane); }
        }
    }
}
__device__ __forceinline__ void phase_mod(const Frame& F0) {
    const Frame F = fresh(F0);
    LAS float* sl = (LAS float*)F.lds;
    LAS float* red = (LAS float*)(F.lds + 98304);
    for (int i = F.tid; i < NB * DM; i += NTHREADS) { const int b = i / DM, d = i % DM; const float c = b < 4 ? argp(F, 2)[b * DM + d] : argp(F, 3)[(b - 4) * DM + d];
        sl[d * NB + b] = c / (1.f + __expf(-c)); }
    __syncthreads();
    const int col = F.tid & 63, kg = F.tid >> 6;
    for (int unit = F.vcu; unit < 4 * 192; unit += F.G) {
        const int l = unit / 192, n0 = (unit % 192) * 64;
        const float* w = argp(F, 6) + (size_t)l * DM * (6 * DM) + n0 + col;
        float acc[NB];
#pragma unroll
        for (int b = 0; b < NB; ++b) acc[b] = 0.f;
        for (int d = kg * 256; d < kg * 256 + 256; ++d) { const float wv = LDG(float, w + (size_t)d * (6 * DM));
            const f32x4 s0 = *(const LAS f32x4*)(sl + d * NB), s1 = *(const LAS f32x4*)(sl + d * NB + 4), s2 = *(const LAS f32x4*)(sl + d * NB + 8);
            acc[0] += wv * s0[0]; acc[1] += wv * s0[1]; acc[2] += wv * s0[2]; acc[3] += wv * s0[3];
            acc[4] += wv * s1[0]; acc[5] += wv * s1[1]; acc[6] += wv * s1[2]; acc[7] += wv * s1[3];
            acc[8] += wv * s2[0]; acc[9] += wv * s2[1]; acc[10] += wv * s2[2]; acc[11] += wv * s2[3]; }
#pragma unroll
        for (int b = 0; b < NB; ++b) red[(kg * NB + b) * 64 + col] = acc[b];
        __syncthreads();
        for (int o = F.tid; o < NB * 64; o += NTHREADS) { const int b = o >> 6, c2 = o & 63; float s = 0.f;
#pragma unroll
            for (int k = 0; k < 8; ++k) s += red[(k * NB + b) * 64 + c2];
            F.mod[((size_t)l * NB + b) * (6 * DM) + n0 + c2] = s + argp(F, 7)[(size_t)l * 6 * DM + n0 + c2]; }
        __syncthreads();
    }
}
__device__ __forceinline__ void phase_norm(const Frame& F0, const float* xp, const float* xs, const float* gain, const float* modl, int sh_chunk, int sc_chunk) {
    const Frame F = fresh(F0);
    for (int row = F.gw; row < TOK; row += F.NGW) {
        const float* xr = (row < TOKP ? xp : xs) + (size_t)row * DM;
        const float* mb = modl + (size_t)batch_of(row) * (6 * DM);
        f32x4 v[8]; float ss = 0.f;
#pragma unroll
        for (int j = 0; j < 8; ++j) { v[j] = LDG(f32x4, xr + 4 * (F.lane + 64 * j)); ss += (v[j][0] * v[j][0] + v[j][1] * v[j][1]) + (v[j][2] * v[j][2] + v[j][3] * v[j][3]); }
        const float rstd = 1.0f / sqrtf(wave_sum(ss) * (1.f / DM) + EPS);
        bf16_t* orow = F.hbuf + (size_t)row * DM;
#pragma unroll
        for (int j = 0; j < 8; ++j) { const int c = 4 * (F.lane + 64 * j);
            const f32x4 g = LDG(f32x4, gain + c), sc = LDG(f32x4, mb + sc_chunk * DM + c), sh = LDG(f32x4, mb + sh_chunk * DM + c);
            const f32x4 y = (v[j] * rstd) * g * (sc + 1.0f) + sh;
            u32x2 w; w.x = cvt_pk_bf16(y[0], y[1]); w.y = cvt_pk_bf16(y[2], y[3]); STG(u32x2, orow + c) = w; }
    }
}
__device__ __forceinline__ void phase_final_norm(const Frame& F0, const float* gain) {
    const Frame F = fresh(F0);
    for (int row = F.gw; row < TOK; row += F.NGW) {
        float* xr = F.out + (size_t)row * DM;
        f32x4 v[8]; float ss = 0.f;
#pragma unroll
        for (int j = 0; j < 8; ++j) { v[j] = LDG(f32x4, xr + 4 * (F.lane + 64 * j)); ss += (v[j][0] * v[j][0] + v[j][1] * v[j][1]) + (v[j][2] * v[j][2] + v[j][3] * v[j][3]); }
        const float rstd = 1.0f / sqrtf(wave_sum(ss) * (1.f / DM) + EPS);
#pragma unroll
        for (int j = 0; j < 8; ++j) { const int c = 4 * (F.lane + 64 * j); const f32x4 g = LDG(f32x4, gain + c); STG(f32x4, xr + c) = (v[j] * rstd) * g; }
    }
}
__device__ __forceinline__ void phase_qknorm_rope(const Frame& F0, const float* qn, const float* kn) {
    const Frame F = fresh(F0);
    const int k16 = F.lane & 15, grp = F.lane >> 4;
    for (int T = F.gw; T < TOK; T += F.NGW) {
        const int S = seq_len_of(T), t = T & (S - 1);
        const float posv = (k16 & 8) ? (float)(t & 63) : (float)(t >> 6);
        float cs[8], sn[8];
#pragma unroll
        for (int e = 0; e < 8; ++e) { const int f = 8 * (k16 & 3) + e; const float invf = exp2f(-(float)f * (13.287712379549449f / 32.f)); sincosf(posv * invf, &sn[e], &cs[e]); }
        const float sgn = (k16 & 4) ? 1.f : -1.f;
        bf16_t* rowp = F.big + (size_t)T * 3072;
        for (int it = 0; it < 5; ++it) {
            const int head = it * 4 + grp;
            bf16_t* p = rowp + head * 128 + 8 * k16;
            const u32x4 raw = LDG(u32x4, p);
            float x[8] = {bf_lo(raw.x), bf_hi(raw.x), bf_lo(raw.y), bf_hi(raw.y), bf_lo(raw.z), bf_hi(raw.z), bf_lo(raw.w), bf_hi(raw.w)};
            float ss = 0.f;
#pragma unroll
            for (int e = 0; e < 8; ++e) ss += x[e] * x[e];
            ss += swz_xor<1>(ss); ss += swz_xor<2>(ss); ss += swz_xor<4>(ss); ss += swz_xor<8>(ss);
            const float rstd = 1.0f / sqrtf(ss * (1.f / 128.f) + EPS);
            const float* gsrc = (head < 16 ? qn : kn) + 8 * k16;
            const float osc = head < 16 ? QSCALE : 1.f;
            float y[8], o[8];
#pragma unroll
            for (int e = 0; e < 8; ++e) y[e] = x[e] * rstd * gsrc[e];
#pragma unroll
            for (int e = 0; e < 8; ++e) { const float partner = swz_xor<4>(y[e]); o[e] = (y[e] * cs[e] + sgn * partner * sn[e]) * osc; }
            u32x4 w; w.x = cvt_pk_bf16(o[0], o[1]); w.y = cvt_pk_bf16(o[2], o[3]); w.z = cvt_pk_bf16(o[4], o[5]); w.w = cvt_pk_bf16(o[6], o[7]);
            STG(u32x4, p) = w;
        }
    }
}

__device__ __forceinline__ void q_to_lds(LAS float* qs, const bf16_t* q, int lane) { const unsigned w = *(const unsigned*)(q + 2 * lane); qs[2 * lane] = bf_lo(w); qs[2 * lane + 1] = bf_hi(w); }
__device__ __forceinline__ float qk_dot(const LAS float* qs, const bf16_t* krow) {
    float s = 0.f;
#pragma unroll
    for (int i = 0; i < 16; ++i) { const u32x4 kv = *(const u32x4*)(krow + 8 * i); const f32x4 qa = *(const LAS f32x4*)(qs + 8 * i), qb = *(const LAS f32x4*)(qs + 8 * i + 4);
        s += qa[0] * bf_lo(kv.x) + qa[1] * bf_hi(kv.x) + qa[2] * bf_lo(kv.y) + qa[3] * bf_hi(kv.y) + qb[0] * bf_lo(kv.z) + qb[1] * bf_hi(kv.z) + qb[2] * bf_lo(kv.w) + qb[3] * bf_hi(kv.w); }
    return s;
}
template <int NV> struct OSt { float m, l; float o[NV / 64]; };
template <int NV> __device__ __forceinline__ void attn_chunk(OSt<NV>& st, float s, int voff, const bf16_t* base, int lane) {
    const float cm = wave_max(s);
    if (cm == -INFINITY) return;
    const float mn = fmaxf(st.m, cm), alpha = __builtin_amdgcn_exp2f(st.m - mn), p = __builtin_amdgcn_exp2f(s - mn);
    st.l = st.l * alpha + wave_sum(p); st.m = mn;
#pragma unroll
    for (int k = 0; k < NV / 64; ++k) st.o[k] *= alpha;
    for (int jj = 0; jj < 64; ++jj) {
        const float pj = __uint_as_float(__builtin_amdgcn_readlane(__float_as_uint(p), jj));
        if (pj != 0.f) { const int off = __builtin_amdgcn_readlane(voff, jj);
            if (NV == 128) { const unsigned w = *(const unsigned*)(base + off + 2 * lane); st.o[0] += pj * bf_lo(w); st.o[1] += pj * bf_hi(w); }
            else { const u32x2 w = *(const u32x2*)(base + off + 4 * lane); st.o[0] += pj * bf_lo(w.x); st.o[1] += pj * bf_hi(w.x); st.o[2] += pj * bf_lo(w.y); st.o[3] += pj * bf_hi(w.y); } }
    }
}
template <int MIX> __device__ __forceinline__ void phase_attn_naive(const Frame& F0) {
    const Frame F = fresh(F0);
    LAS float* qs = (LAS float*)(F.lds + F.wave * 1024);
    const int NH = (MIX == 2) ? 8 : 16, W = (MIX == 2) ? 4096 : 3072;
    const bf16_t* qkv = F.big;
    for (int job = F.gw; job < TOK * NH; job += F.NGW) {
        const int T = job / NH, h = job % NH, S = seq_len_of(T), sb = T & ~(S - 1), t = T - sb;
        if (MIX != 2) {
            const int kvh = h >> 2, kcol = 2048 + kvh * 128, vcol = 2560 + kvh * 128;
            q_to_lds(qs, qkv + (size_t)T * W + h * 128, F.lane);
            asm volatile("s_waitcnt lgkmcnt(0)" ::: "memory");
            OSt<128> st; st.m = -1e30f; st.l = 0.f; st.o[0] = 0.f; st.o[1] = 0.f;
            const float slope2 = exp2f(-0.5f * (float)(h + 1)) * LOG2E;
            if (MIX == 0) {
                for (int c = 0; c < S / 64; ++c) { const int pos = 64 * c + F.lane; const int ro = (sb + pos) * W;
                    const float s = qk_dot(qs, qkv + ro + kcol); attn_chunk<128>(st, s, ro + vcol, qkv, F.lane); }
            } else if (MIX == 1) {
                st.m = argp(F, 13)[h] * LOG2E; st.l = 1.f;
                for (int c = 0; c < 5; ++c) { const int pos = t - 128 + 64 * c + F.lane; const int d = pos - t; const bool valid = (d >= -128) && (d <= 128) && (pos >= 0) && (pos < S);
                    const int pc = pos < 0 ? 0 : (pos > S - 1 ? S - 1 : pos); const int ro = (sb + pc) * W;
                    float s = qk_dot(qs, qkv + ro + kcol) - slope2 * fabsf((float)d); s = valid ? s : -INFINITY; attn_chunk<128>(st, s, ro + vcol, qkv, F.lane); }
            } else {
#pragma unroll
                for (int br = 0; br < 3; ++br) { const int dil = br == 0 ? 1 : br == 1 ? 4 : 16;
                    for (int c = 0; c < 3; ++c) { const int j = -64 + 64 * c + F.lane; const int pos = t + dil * j; const bool valid = (j <= 64) && (pos >= 0) && (pos < S);
                        const int pc = pos < 0 ? 0 : (pos > S - 1 ? S - 1 : pos); const int ro = (sb + pc) * W;
                        float s = qk_dot(qs, qkv + ro + kcol) - slope2 * (float)dil * fabsf((float)j); s = valid ? s : -INFINITY; attn_chunk<128>(st, s, ro + vcol, qkv, F.lane); } }
            }
            const float rl = 1.0f / st.l;
            *(unsigned*)(F.hbuf + (size_t)T * DM + h * 128 + 2 * F.lane) = cvt_pk_bf16(st.o[0] * rl, st.o[1] * rl);
        } else {
            const int kvh = h >> 1; const float slope2 = exp2f(-(float)(h + 1)) * LOG2E;
            const float* lp = argp(F, 16);
            const float d1 = wave_sum(lp[F.lane] * lp[128 + F.lane] + lp[64 + F.lane] * lp[192 + F.lane]);
            const float d2 = wave_sum(lp[256 + F.lane] * lp[384 + F.lane] + lp[320 + F.lane] * lp[448 + F.lane]);
            const float lam = expf(d1) - expf(d2) + LAM_INIT2;
            float om[2][4];
#pragma unroll
            for (int mp = 0; mp < 2; ++mp) {
                const int kcol = 2048 + kvh * 256 + mp * 128, vcol = 3072 + kvh * 256;
                q_to_lds(qs, qkv + (size_t)T * W + h * 256 + mp * 128, F.lane);
                asm volatile("s_waitcnt lgkmcnt(0)" ::: "memory");
                OSt<256> st; st.m = -1e30f; st.l = 0.f; st.o[0] = st.o[1] = st.o[2] = st.o[3] = 0.f;
                for (int c = 0; c < S / 64; ++c) { const int pos = 64 * c + F.lane; const int ro = (sb + pos) * W;
                    const float s = qk_dot(qs, qkv + ro + kcol) - slope2 * fabsf((float)(pos - t)); attn_chunk<256>(st, s, ro + vcol, qkv, F.lane); }
                const float rl = 1.0f / st.l;
#pragma unroll
                for (int k = 0; k < 4; ++k) om[mp][k] = st.o[k] * rl;
                asm volatile("s_waitcnt lgkmcnt(0)" ::: "memory");
            }
            float dd[4], ss = 0.f;
#pragma unroll
            for (int k = 0; k < 4; ++k) { dd[k] = om[0][k] - lam * om[1][k]; ss += dd[k] * dd[k]; }
            const float rstd = 1.0f / sqrtf(wave_sum(ss) * (1.f / 256.f) + EPS);
            const f32x4 sg = *(const f32x4*)(argp(F, 17) + 4 * F.lane);
            u32x2 w; w.x = cvt_pk_bf16(dd[0] * rstd * sg[0] * (1.f - LAM_INIT2), dd[1] * rstd * sg[1] * (1.f - LAM_INIT2));
            w.y = cvt_pk_bf16(dd[2] * rstd * sg[2] * (1.f - LAM_INIT2), dd[3] * rstd * sg[3] * (1.f - LAM_INIT2));
            *(u32x2*)(F.hbuf + (size_t)T * DM + h * 256 + 4 * F.lane) = w;
        }
    }
}

namespace fa {
using f32x16 = __attribute__((ext_vector_type(16))) float;
using s16x4  = __attribute__((ext_vector_type(4))) short;
constexpr int KVBLK = 64;
constexpr int SHM_V = KVBLK * 128 * 2, SHM_K = SHM_V;
constexpr float THR2 = 8.f * LOG2E;
#define KSWZ(row, colB) ((row) * 256 + ((colB) ^ (((row) & 7) << 4)))
#define SBAR() __builtin_amdgcn_sched_barrier(0)
__device__ __forceinline__ int crow(int r, int hi) { return (r & 3) + 8 * (r >> 2) + 4 * hi; }
__device__ __forceinline__ int v_st(int k, int c) { const int kk = (k & ~0xC) | ((k & 4) << 1) | ((k & 8) >> 1); return ((kk >> 3) * 4 + (c >> 5)) * 512 + ((kk & 7) * 32 + (c & 31)) * 2; }
__device__ __forceinline__ int v_rd_base(int lane) { return ((lane & 3) << 3) | (((lane >> 2) & 3) << 6) | (((lane >> 4) & 1) << 5) | (((lane >> 5) & 1) << 8); }
constexpr int v_rd_off(int d0, int ks, int half) { return d0 * 512 + ks * 4096 + half * 2048; }
template <int OFF> __device__ __forceinline__ s16x4 tr_read(int vb) { s16x4 r; asm volatile("ds_read_b64_tr_b16 %0, %1 offset:%2" : "=&v"(r) : "v"(vb), "i"(OFF) : "memory"); return r; }
template <int D0> __device__ __forceinline__ void pv_one(f32x16& od, int vb, bf16x8 pa0, bf16x8 pa1, bf16x8 pa2, bf16x8 pa3) {
  const s16x4 l0 = tr_read<v_rd_off(D0, 0, 0)>(vb), h0 = tr_read<v_rd_off(D0, 0, 1)>(vb), l1 = tr_read<v_rd_off(D0, 1, 0)>(vb), h1 = tr_read<v_rd_off(D0, 1, 1)>(vb);
  const s16x4 l2 = tr_read<v_rd_off(D0, 2, 0)>(vb), h2 = tr_read<v_rd_off(D0, 2, 1)>(vb), l3 = tr_read<v_rd_off(D0, 3, 0)>(vb), h3 = tr_read<v_rd_off(D0, 3, 1)>(vb);
  asm volatile("s_waitcnt lgkmcnt(0)" ::: "memory"); SBAR();
#define PK(L, H) (bf16x8){L[0], L[1], L[2], L[3], H[0], H[1], H[2], H[3]}
  od = __builtin_amdgcn_mfma_f32_32x32x16_bf16(pa0, PK(l0, h0), od, 0, 0, 0);
  od = __builtin_amdgcn_mfma_f32_32x32x16_bf16(pa1, PK(l1, h1), od, 0, 0, 0);
  od = __builtin_amdgcn_mfma_f32_32x32x16_bf16(pa2, PK(l2, h2), od, 0, 0, 0);
  od = __builtin_amdgcn_mfma_f32_32x32x16_bf16(pa3, PK(l3, h3), od, 0, 0, 0);
#undef PK
}
__device__ __forceinline__ void pv_d0(f32x16* o, int vb, bf16x8 pa0, bf16x8 pa1, bf16x8 pa2, bf16x8 pa3) {
  pv_one<0>(o[0], vb, pa0, pa1, pa2, pa3); pv_one<1>(o[1], vb, pa0, pa1, pa2, pa3); pv_one<2>(o[2], vb, pa0, pa1, pa2, pa3); pv_one<3>(o[3], vb, pa0, pa1, pa2, pa3);
}
__device__ __forceinline__ void qkt(f32x16& p0, f32x16& p1, const LAS char* Ks, const bf16x8* qr, int r32, int hi) {
  p0 = f32x16{}; p1 = f32x16{};
#pragma unroll
  for (int d0 = 0; d0 < 8; ++d0) { const int cb = (d0 * 16 + hi * 8) * 2;
    const bf16x8 b0 = *(const LAS bf16x8*)(Ks + KSWZ(r32, cb));
    const bf16x8 b1 = *(const LAS bf16x8*)(Ks + KSWZ(32 + r32, cb));
    p0 = __builtin_amdgcn_mfma_f32_32x32x16_bf16(b0, qr[d0], p0, 0, 0, 0);
    p1 = __builtin_amdgcn_mfma_f32_32x32x16_bf16(b1, qr[d0], p1, 0, 0, 0); }
}
template <int WIN, bool ALIBI>
__device__ __forceinline__ void partialSM(f32x16& p0, f32x16& p1, float& m_reg, float& mn, float& alpha, float dub, float nslope, float lo, float hi_, bool tile_ok) {
  if (ALIBI || WIN) {
#pragma unroll
    for (int r = 0; r < 16; ++r) { const float c = (float)((r & 3) + 8 * (r >> 2)); const float du0 = dub + c, du1 = dub + (c + 32.f);
      float t0 = p0[r], t1 = p1[r];
      if (ALIBI) { t0 = fmaf(fabsf(du0), nslope, t0); t1 = fmaf(fabsf(du1), nslope, t1); }
      if (WIN) { t0 = (du0 >= lo && du0 <= hi_) ? t0 : -INFINITY; t1 = (du1 >= lo && du1 <= hi_) ? t1 : -INFINITY; }
      p0[r] = t0; p1[r] = t1; }
    if (WIN) { if (!tile_ok) {
#pragma unroll
      for (int r = 0; r < 16; ++r) { p0[r] = -INFINITY; p1[r] = -INFINITY; } } }
  }
  float pmax = p0[0];
#pragma unroll
  for (int r = 1; r < 16; ++r) pmax = fmaxf(pmax, p0[r]);
#pragma unroll
  for (int r = 0; r < 16; ++r) pmax = fmaxf(pmax, p1[r]);
  { auto rr = __builtin_amdgcn_permlane32_swap(__float_as_uint(pmax), __float_as_uint(pmax), false, false);
    pmax = fmaxf(__uint_as_float(rr[0]), __uint_as_float(rr[1])); }
  if (__builtin_expect(__all(pmax - m_reg <= THR2), 1)) { mn = m_reg; alpha = 1.f; }
  else { mn = fmaxf(m_reg, pmax); alpha = __builtin_amdgcn_exp2f(m_reg - mn); m_reg = mn; }
#pragma unroll
  for (int r = 0; r < 16; ++r) { p0[r] = p0[r] - mn; p1[r] = p1[r] - mn; }
#pragma unroll
  for (int r = 0; r < 16; ++r) p0[r] = __builtin_amdgcn_exp2f(p0[r]);
}
__device__ __forceinline__ void finishSM(f32x16& p0, f32x16& p1, float alpha, float& l_reg, bf16x8& pa0, bf16x8& pa1, bf16x8& pa2, bf16x8& pa3) {
#pragma unroll
  for (int r = 0; r < 16; ++r) p1[r] = __builtin_amdgcn_exp2f(p1[r]);
  float ps = 0;
#pragma unroll
  for (int r = 0; r < 16; ++r) ps += p0[r];
#pragma unroll
  for (int r = 0; r < 16; ++r) ps += p1[r];
  { auto rr = __builtin_amdgcn_permlane32_swap(__float_as_uint(ps), __float_as_uint(ps), false, false);
    ps = __uint_as_float(rr[0]) + __uint_as_float(rr[1]); }
  l_reg = l_reg * alpha + ps;
#define PK4(P, BASE, OUT) do { unsigned a0 = cvt_pk_bf16(P[BASE + 0], P[BASE + 1]), a1 = cvt_pk_bf16(P[BASE + 2], P[BASE + 3]);   \
    unsigned b0 = cvt_pk_bf16(P[BASE + 4], P[BASE + 5]), b1 = cvt_pk_bf16(P[BASE + 6], P[BASE + 7]);                              \
    auto r0 = __builtin_amdgcn_permlane32_swap(a0, b0, false, false); auto r1 = __builtin_amdgcn_permlane32_swap(a1, b1, false, false); \
    u32x4 w = {r0[0], r1[0], r0[1], r1[1]}; OUT = *reinterpret_cast<bf16x8*>(&w); } while (0)
  PK4(p0, 0, pa0); PK4(p0, 8, pa1); PK4(p1, 0, pa2); PK4(p1, 8, pa3);
#undef PK4
}
struct Item {
  const bf16_t* qkv; int W;
  bf16_t* O; int ocol;
  float* lse; int hh;
  int seq_base, SU, dil, c0, u0, ukb0, NT, two;
  int qcol, kcol, vcol;
  float nslope, sink2, nlam;
};
template <int WIN, bool ALIBI, int EPI, bool SINK>
__device__ __forceinline__ void attn_item(const Item& I, char* lds) {
  int tid = threadIdx.x; asm volatile("" : "+v"(tid));
  const int wid = __builtin_amdgcn_readfirstlane(tid >> 6), lane = tid & 63, r32 = lane & 31, hi = lane >> 5;
  LAS char* V_lds = (LAS char*)lds; LAS char* K_lds = V_lds + 2 * SHM_V;
  LAS float* wsf = (LAS float*)(V_lds + 2 * SHM_V + 2 * SHM_K) + wid * 64; LAS float* li_l = wsf; LAS float* al_l = wsf + 32;
  float m_reg = SINK ? I.sink2 : -1e30f, l_reg = SINK ? 1.f : 0.f; f32x16 o[4] = {}; bf16x8 qr[8];
  const int two = I.two;
  const int wcls = two ? (wid >> 2) : 0;
  const int uq = I.u0 + (two ? ((wid & 3) * 32 + r32) : (wid * 32 + r32));
  { const bf16_t* Qw = I.qkv + (size_t)(I.seq_base + I.c0 + wcls + I.dil * uq) * I.W + I.qcol + hi * 8;
#pragma unroll
    for (int d0 = 0; d0 < 8; ++d0) qr[d0] = LDG(bf16x8, Qw + d0 * 16); }
  const float lo = WIN ? (float)max(-WIN, -uq) : 0.f, hi_ = WIN ? (float)min(WIN, I.SU - 1 - uq) : 0.f;
  const float dq = (float)(4 * hi - uq);
  const int sr = tid >> 4, sc = (tid & 15) * 8, vst0 = v_st(sr, sc), vst1 = v_st(32 + sr, sc);
  const int vb0 = (int)(unsigned)(uintptr_t)V_lds + v_rd_base(lane);
  struct { bf16x8 vs0, vs1, ks0, ks1; } sr_[2];
#define TILE_UKB(n) (two ? 64 * ((n) & 1) : I.ukb0 + 64 * (n))
#define TILE_OK(n) (!two || ((n) >> 1) == (wid >> 2))
#define SLOAD(i, n) do { const int ukb_ = TILE_UKB(n); const int cls_ = I.c0 + (two ? ((n) >> 1) : 0); int u0_ = ukb_ + sr, u1_ = ukb_ + 32 + sr; \
    if (WIN) { u0_ = min(max(u0_, 0), I.SU - 1); u1_ = min(max(u1_, 0), I.SU - 1); } \
    const bf16_t* r0_ = I.qkv + (size_t)(I.seq_base + cls_ + I.dil * u0_) * I.W + sc; const bf16_t* r1_ = I.qkv + (size_t)(I.seq_base + cls_ + I.dil * u1_) * I.W + sc; \
    sr_[i].vs0 = LDG(bf16x8, r0_ + I.vcol); sr_[i].vs1 = LDG(bf16x8, r1_ + I.vcol); \
    sr_[i].ks0 = LDG(bf16x8, r0_ + I.kcol); sr_[i].ks1 = LDG(bf16x8, r1_ + I.kcol); } while (0)
#define SWRITE(b, i) do { *(LAS bf16x8*)(V_lds + (b) * SHM_V + vst0) = sr_[i].vs0; *(LAS bf16x8*)(V_lds + (b) * SHM_V + vst1) = sr_[i].vs1; const int kc = sc * 2; \
    *(LAS bf16x8*)(K_lds + (b) * SHM_K + KSWZ(sr, kc)) = sr_[i].ks0; *(LAS bf16x8*)(K_lds + (b) * SHM_K + KSWZ(32 + sr, kc)) = sr_[i].ks1; } while (0)
#define SWAIT() asm volatile("s_waitcnt vmcnt(4)" ::: "memory")
#define RESC(a) do { if (__any((a) < 1.f)) { if (hi == 0) al_l[r32] = (a); asm volatile("s_waitcnt lgkmcnt(0)" ::: "memory"); \
    _Pragma("unroll") for (int d = 0; d < 4; ++d) _Pragma("unroll") for (int r = 0; r < 16; ++r) o[d][r] *= al_l[crow(r, hi)]; } } while (0)
#define PSM(P0, P1, MN, AL, n) partialSM<WIN, ALIBI>(P0, P1, m_reg, MN, AL, dq + (float)TILE_UKB(n), I.nslope, lo, hi_, TILE_OK(n))
  f32x16 pA0, pA1, pB0, pB1; float mnA, mnB, alA, alB; bf16x8 pa0, pa1, pa2, pa3; const int NT = I.NT;
  constexpr int SE = 0, SO = 1;
  SLOAD(SE, 0); asm volatile("s_waitcnt vmcnt(0)" ::: "memory"); SWRITE(0, SE); __syncthreads();
  qkt(pA0, pA1, K_lds, qr, r32, hi); PSM(pA0, pA1, mnA, alA, 0);
  SLOAD(SO, 1); if (2 < NT) SLOAD(SE, 2);
  SWAIT(); SWRITE(1, SO); __syncthreads();
  for (int j = 1; j + 1 < NT; j += 2) {
    SBAR(); qkt(pB0, pB1, K_lds + SHM_K, qr, r32, hi);
    finishSM(pA0, pA1, alA, l_reg, pa0, pa1, pa2, pa3); SBAR();
    SLOAD(SO, j + 2); SBAR();
    pv_d0(o, vb0, pa0, pa1, pa2, pa3); PSM(pB0, pB1, mnB, alB, j);
    __syncthreads(); SWAIT(); SWRITE(0, SE);
    RESC(alB); __syncthreads();
    SBAR(); qkt(pA0, pA1, K_lds, qr, r32, hi);
    finishSM(pB0, pB1, alB, l_reg, pa0, pa1, pa2, pa3); SBAR();
    if (j + 3 < NT) SLOAD(SE, j + 3); SBAR();
    pv_d0(o, vb0 + SHM_V, pa0, pa1, pa2, pa3); PSM(pA0, pA1, mnA, alA, j + 1);
    __syncthreads(); SWAIT(); SWRITE(1, SO);
    RESC(alA); __syncthreads();
  }
  SBAR(); qkt(pB0, pB1, K_lds + SHM_K, qr, r32, hi);
  finishSM(pA0, pA1, alA, l_reg, pa0, pa1, pa2, pa3); SBAR();
  pv_d0(o, vb0, pa0, pa1, pa2, pa3); PSM(pB0, pB1, mnB, alB, NT - 1);
  __syncthreads(); RESC(alB);
  finishSM(pB0, pB1, alB, l_reg, pa0, pa1, pa2, pa3); SBAR();
  pv_d0(o, vb0 + SHM_V, pa0, pa1, pa2, pa3);
  const int tokq = I.seq_base + I.c0 + wcls + I.dil * uq;
  if (EPI == 0 || EPI == 1 || EPI == 3) { if (hi == 0) { li_l[r32] = (EPI == 3 ? I.nlam : 1.f) / l_reg; if (EPI == 1) STG(float, I.lse + (size_t)tokq * 16 + I.hh) = m_reg + __log2f(l_reg); } }
  if (EPI == 2) { if (hi == 0) { float* lp = I.lse + (size_t)tokq * 16 + I.hh; const float lold = LDG(float, lp), lcur = m_reg + __log2f(l_reg), mx = fmaxf(lold, lcur);
      const float wa = __builtin_amdgcn_exp2f(lold - mx), wb = __builtin_amdgcn_exp2f(lcur - mx), den = wa + wb; STG(float, lp) = mx + __log2f(den);
      al_l[r32] = wa / den; li_l[r32] = wb / (den * l_reg); } }
  asm volatile("s_waitcnt lgkmcnt(0)" ::: "memory");
  const int tokw = I.seq_base + I.c0 + wcls + I.dil * (I.u0 + (two ? (wid & 3) * 32 : wid * 32));
  bf16_t* Ow = I.O + (size_t)tokw * DM + I.ocol + r32;
#pragma unroll
  for (int r = 0; r < 16; ++r) { const int orow = crow(r, hi); const float f = li_l[orow]; const float fo = (EPI == 2) ? al_l[orow] : 1.f;
    bf16_t* Or = Ow + (size_t)(I.dil * orow) * DM;
#pragma unroll
    for (int d0 = 0; d0 < 4; ++d0) { float v = o[d0][r] * f;
      if (EPI == 2 || EPI == 3) { const float old = __uint_as_float((unsigned)LDG(bf16_t, Or + d0 * 32) << 16); v = fo * old + v; }
      STG(bf16_t, Or + d0 * 32) = (bf16_t)(cvt_pk_bf16(v, v) & 0xffffu); } }
  __syncthreads();
#undef TILE_UKB
#undef TILE_OK
#undef SLOAD
#undef SWRITE
#undef SWAIT
#undef RESC
#undef PSM
}
#undef KSWZ
#undef SBAR
}

struct ItemId { int seq_base, S, h, qb; };
__device__ __forceinline__ ItemId item_decode(int it) { ItemId d;
  if (it < 2048) { d.S = SS_; d.seq_base = TOKP + (it >> 8) * SS_; d.h = (it >> 4) & 15; d.qb = it & 15; }
  else { const int r = it - 2048; d.S = SP_; d.seq_base = (r >> 7) * SP_; d.h = (r >> 3) & 15; d.qb = r & 7; }
  return d; }
template <int MODE> __device__ __forceinline__ void phase_attn_fast(const Frame& F0) {
  const Frame F = fresh(F0);
  float nlam = 0.f;
  if (MODE == 3) { const float* lp = argp(F, 16);
    const float d1 = wave_sum(lp[F.lane] * lp[128 + F.lane] + lp[64 + F.lane] * lp[192 + F.lane]);
    const float d2 = wave_sum(lp[256 + F.lane] * lp[384 + F.lane] + lp[320 + F.lane] * lp[448 + F.lane]);
    nlam = -(expf(d1) - expf(d2) + LAM_INIT2); }
  for (int i = 0;; ++i) {
    const int it = i * F.G + F.vcu; if (it >= 2560) break;
    const ItemId d = item_decode(it);
    fa::Item I; I.qkv = F.big; I.O = F.hbuf; I.lse = F.lse; I.seq_base = d.seq_base; I.two = 0; I.dil = 1; I.c0 = 0; I.SU = d.S; I.u0 = 256 * d.qb; I.hh = d.h;
    I.nslope = 0.f; I.sink2 = 0.f; I.nlam = nlam;
    if (MODE == 2 || MODE == 3) { const int hq = d.h >> 1, vh = d.h & 1, kvh = hq >> 1, mp = (MODE == 3) ? 1 : 0;
      I.W = 4096; I.qcol = hq * 256 + mp * 128; I.kcol = 2048 + kvh * 256 + mp * 128; I.vcol = 3072 + kvh * 256 + vh * 128; I.ocol = hq * 256 + vh * 128;
      I.nslope = -exp2f(-(float)(hq + 1)) * LOG2E; I.ukb0 = 0; I.NT = d.S / 64;
      if (MODE == 2) fa::attn_item<0, true, 0, false>(I, (char*)F.lds); else fa::attn_item<0, true, 3, false>(I, (char*)F.lds);
    } else { const int kvh = d.h >> 2; I.W = 3072; I.qcol = d.h * 128; I.kcol = 2048 + kvh * 128; I.vcol = 2560 + kvh * 128; I.ocol = d.h * 128;
      const float slope2 = exp2f(-0.5f * (float)(d.h + 1)) * LOG2E;
      if (MODE == 0) { I.ukb0 = 0; I.NT = d.S / 64; fa::attn_item<0, false, 0, false>(I, (char*)F.lds); }
      if (MODE == 1) { I.ukb0 = I.u0 - 128; I.NT = 8; I.nslope = -slope2; I.sink2 = argp(F, 13)[d.h] * LOG2E; fa::attn_item<128, true, 0, true>(I, (char*)F.lds); }
      if (MODE == 4) { I.ukb0 = I.u0 - 64; I.NT = 6; I.nslope = -slope2; fa::attn_item<64, true, 1, false>(I, (char*)F.lds); }
      if (MODE == 5 || MODE == 6) { const int dil = (MODE == 5) ? 4 : 16; I.dil = dil; I.SU = d.S / dil; I.nslope = -slope2 * (float)dil;
        const int nqc = I.SU / 256;
        if (nqc == 0) { I.two = 1; I.c0 = 2 * d.qb; I.u0 = 0; I.ukb0 = 0; I.NT = 4; }
        else { I.c0 = d.qb / nqc; I.u0 = 256 * (d.qb % nqc); I.ukb0 = I.u0 - 64; I.NT = 6; }
        fa::attn_item<64, true, 2, false>(I, (char*)F.lds); }
    }
  }
}
__device__ __forceinline__ void phase_subln(const Frame& F0) {
  const Frame F = fresh(F0);
  const int k32 = F.lane & 31, half = F.lane >> 5;
  const float* sg = argp(F, 17) + 8 * k32;
  float g[8];
#pragma unroll
  for (int e = 0; e < 8; ++e) g[e] = sg[e] * (1.f - LAM_INIT2);
  for (int T = F.gw; T < TOK; T += F.NGW) {
#pragma unroll
    for (int it = 0; it < 4; ++it) { bf16_t* p = F.hbuf + (size_t)T * DM + (it * 2 + half) * 256 + 8 * k32;
      const u32x4 raw = LDG(u32x4, p);
      float x[8] = {bf_lo(raw.x), bf_hi(raw.x), bf_lo(raw.y), bf_hi(raw.y), bf_lo(raw.z), bf_hi(raw.z), bf_lo(raw.w), bf_hi(raw.w)};
      float ss = 0.f;
#pragma unroll
      for (int e = 0; e < 8; ++e) ss += x[e] * x[e];
      ss += swz_xor<1>(ss); ss += swz_xor<2>(ss); ss += swz_xor<4>(ss); ss += swz_xor<8>(ss); ss += swz_xor<16>(ss);
      const float rstd = 1.0f / sqrtf(ss * (1.f / 256.f) + EPS);
      u32x4 w; w.x = cvt_pk_bf16(x[0] * rstd * g[0], x[1] * rstd * g[1]); w.y = cvt_pk_bf16(x[2] * rstd * g[2], x[3] * rstd * g[3]);
      w.z = cvt_pk_bf16(x[4] * rstd * g[4], x[5] * rstd * g[5]); w.w = cvt_pk_bf16(x[6] * rstd * g[6], x[7] * rstd * g[7]);
      STG(u32x4, p) = w; }
  }
}

__global__ void __launch_bounds__(NTHREADS, 2) fwd(Args args) {
    extern __shared__ __attribute__((aligned(16))) unsigned char lds_raw[];
    Frame F;
    F.lds = (LAS unsigned char*)lds_raw;
    F.tid = threadIdx.x; F.lane = F.tid & 63; F.wave = __builtin_amdgcn_readfirstlane(F.tid >> 6);
    F.G = gridDim.x; { const int bx = blockIdx.x; F.vcu = (F.G % 8 == 0) ? (bx % 8) * (F.G / 8) + bx / 8 : bx; }
    F.gw = F.vcu * NWAVES + F.wave; F.NGW = F.G * NWAVES;
    F.kargs = (unsigned long long)__builtin_amdgcn_kernarg_segment_ptr(); F.out = args.out; F.ws = args.ws;
    F.hbuf = (bf16_t*)(args.ws + WS_H) + (size_t)256 * DM; F.big = (bf16_t*)(args.ws + WS_BIG); F.mod = (float*)(args.ws + WS_MOD); F.lse = (float*)(args.ws + WS_LSE);
    volatile LAS unsigned* MISC = (volatile LAS unsigned*)(F.lds + MISC_OFF);
    if (F.tid < 32) MISC[F.tid] = 0u;
    __syncthreads();
    unsigned* barw = (unsigned*)(args.ws + WS_CTL) + CW_BAR;
    XcdBarrier bar; bar.bar = barw; bar.x = 0; bar.st = nullptr;
    if (!MK_MULTI) bar = xcd_barrier_post(barw, MISC + 8);
    const int lo = args.ph_lo, hi = args.ph_hi;
#ifndef PHSEL
#define PHSEL(k) 1
#endif
#define IN(k) (PHSEL(k) && lo <= (k) && (k) < hi)
#define SEAM(k) do { if (!MK_MULTI) xcd_barrier(bar); } while (0)

    if (IN(0)) { phase_mod(F); __syncthreads(); phase_weights(F); SEAM(0); }

    for (int L0 = 0; L0 < 4; ++L0) {
        const int pb = 1 + 10 * L0;
#define LAYER_VARS() const Frame P = fresh(F); int L = L0; asm volatile("" : "+s"(L)); const float* modl = P.mod + (size_t)L * NB * 6 * DM; \
        const float* xin_p = (L == 0) ? argp(P, 0) : P.out; const float* xin_s = (L == 0) ? argp(P, 1) - (size_t)TOKP * DM : P.out; const int NQ = (L == 2) ? 4096 : 3072; (void)modl; (void)xin_p; (void)xin_s; (void)NQ
        if (IN(pb + 0)) { LAYER_VARS(); phase_norm(P, xin_p, xin_s, argp(P, 4) + L * DM, modl, 0, 1); SEAM(pb + 0); }
        if (IN(pb + 1)) { LAYER_VARS();
            pg8::Gemm g{P.hbuf, wt_ptr(P, L, WT_QKV), DM}; pg8::StaticOrder S; S.init(TOK / 256, NQ / 256, P.G, (int)blockIdx.x);
            pg8::EpiQKV E{P.big, NQ, 2048, (L == 0) ? 1.0f : QSCALE};
            pg8::gemm_phase<pg8::EpiQKV, 0>(P.lds, g, S, E);
            SEAM(pb + 1);
        }
        if (L0 == 0) {
            if (IN(pb + 2)) { phase_qknorm_rope(F, argp(F, 9), argp(F, 10)); SEAM(pb + 2); }
#if NAIVE_A
            if (IN(pb + 3)) { phase_attn_naive<0>(F); SEAM(pb + 3); }
#else
            if (IN(pb + 3)) { phase_attn_fast<0>(F); SEAM(pb + 3); }
#endif
        } else if (L0 == 1) {
#if NAIVE_B
            if (IN(pb + 2)) { phase_attn_naive<1>(F); SEAM(pb + 2); }
#else
            if (IN(pb + 2)) { phase_attn_fast<1>(F); SEAM(pb + 2); }
#endif
        } else if (L0 == 2) {
#if NAIVE_C
            if (IN(pb + 2)) { phase_attn_naive<2>(F); SEAM(pb + 2); }
#else
            if (IN(pb + 2)) { phase_attn_fast<2>(F); SEAM(pb + 2); }
            if (IN(pb + 3)) { phase_attn_fast<3>(F); SEAM(pb + 3); }
            if (IN(pb + 4)) { phase_subln(F); SEAM(pb + 4); }
#endif
        } else {
#if NAIVE_D
            if (IN(pb + 2)) { phase_attn_naive<3>(F); SEAM(pb + 2); }
#else
            if (IN(pb + 2)) { phase_attn_fast<4>(F); SEAM(pb + 2); }
            if (IN(pb + 3)) { phase_attn_fast<5>(F); SEAM(pb + 3); }
            if (IN(pb + 4)) { phase_attn_fast<6>(F); SEAM(pb + 4); }
#endif
        }
        if (IN(pb + 5)) { LAYER_VARS();
            pg8::Gemm g{P.hbuf, wt_ptr(P, L, WT_WO), DM}; pg8::StaticOrder S; S.init(TOK / 256, DM / 256, P.G, (int)blockIdx.x);
            pg8::EpiRes E{xin_p, xin_s, P.out, modl + 2 * DM};
            pg8::gemm_phase<pg8::EpiRes, 0>(P.lds, g, S, E);
            SEAM(pb + 5);
        }
        if (IN(pb + 6)) { LAYER_VARS(); phase_norm(P, P.out, P.out, argp(P, 5) + L * DM, modl, 3, 4); SEAM(pb + 6); }
        if (IN(pb + 7)) { LAYER_VARS();
            pg8::Gemm g{P.hbuf, wt_ptr(P, L, WT_UP), DM}; pg8::StaticOrder S; S.init(163, DFF / 128, P.G, (int)blockIdx.x);
            pg8::EpiGLU E{P.big, argp(P, 22) + (size_t)L * 3 * DFF, argp(P, 23) + (size_t)L * DFF};
            pg8::gemm_phase<pg8::EpiGLU, 1>(P.lds, g, S, E);
            SEAM(pb + 7);
        }
        if (IN(pb + 8)) { LAYER_VARS();
            pg8::Gemm g{P.big, wt_ptr(P, L, WT_DOWN), DFF}; pg8::StaticOrder S; S.init(TOK / 256, DM / 256, P.G, (int)blockIdx.x);
            pg8::EpiRes E{P.out, P.out, P.out, modl + 5 * DM};
            pg8::gemm_phase<pg8::EpiRes, 0>(P.lds, g, S, E);
            SEAM(pb + 8);
        }
#undef LAYER_VARS
    }
    if (IN(41)) phase_final_norm(F, argp(F, 25));
#undef IN
#undef SEAM
}

extern "C" void kernel_launch(void* const* d_in, const int* in_sizes, int n_in, void* d_out, int out_size, void* d_ws, size_t ws_size, hipStream_t stream) {
    static int grid = 0;
    if (grid == 0) {
        if (n_in != 26 || out_size != TOK * DM || ws_size < WS_END) { fprintf(stderr, "kernel_launch: unexpected shapes (n_in %d out %d ws %zu)\n", n_in, out_size, ws_size); grid = -1; return; }
        int dev = 0, cus = 0, per_cu = 0;
        if (hipGetDevice(&dev) != hipSuccess || hipDeviceGetAttribute(&cus, hipDeviceAttributeMultiprocessorCount, dev) != hipSuccess) { grid = -1; return; }
        if (hipFuncSetAttribute((const void*)fwd, hipFuncAttributeMaxDynamicSharedMemorySize, LDS_BYTES) != hipSuccess) { fprintf(stderr, "kernel_launch: hipFuncSetAttribute failed\n"); grid = -1; return; }
        if (hipOccupancyMaxActiveBlocksPerMultiprocessor(&per_cu, (const void*)fwd, NTHREADS, LDS_BYTES) != hipSuccess || per_cu < 1) fprintf(stderr, "kernel_launch: occupancy query says %d\n", per_cu);
        (void)hipGetLastError();
        grid = cus;
    }
    if (grid < 0) return;
    (void)hipMemsetAsync((char*)d_ws + WS_CTL, 0, CTL_ZERO_BYTES, stream);
    Args a{};
    for (int i = 0; i < 26; ++i) a.in[i] = (const float*)d_in[i];
    a.out = (float*)d_out; a.ws = (unsigned char*)d_ws;
#if MK_MULTI
    for (int p = 0; p < 42; ++p) {
        const int r = (p - 1) % 10, L = (p - 1) / 10;
        if (p >= 1 && p <= 40) { if (r == 9) continue; if (r == 4 && !((L == 2 && !NAIVE_C) || (L == 3 && !NAIVE_D))) continue; if (r == 3 && !(L == 0 || (L == 2 && !NAIVE_C) || (L == 3 && !NAIVE_D))) continue; }
        a.ph_lo = p; a.ph_hi = p + 1;
        hipLaunchKernelGGL(fwd, dim3(grid), dim3(NTHREADS), LDS_BYTES, stream, a);
    }
#else
    a.ph_lo = 0; a.ph_hi = 42;
    hipLaunchKernelGGL(fwd, dim3(grid), dim3(NTHREADS), LDS_BYTES, stream, a);
#endif
}
```

```cpp
#include <hip/hip_runtime.h>
#include <cstdio>
#include <cstdint>

#ifndef MK_MULTI
#define MK_MULTI 0
#endif
#ifndef NAIVE_A
#define NAIVE_A 0
#endif
#ifndef NAIVE_B
#define NAIVE_B 0
#endif
#ifndef NAIVE_C
#define NAIVE_C 0
#endif
#ifndef NAIVE_D
#define NAIVE_D 0
#endif

#ifndef PROBE_MASK
#define PROBE_MASK 0
#endif
#define REPS(k) (((PROBE_MASK >> (k)) & 1) ? 2 : 1)
#ifndef STAG_QKV
#define STAG_QKV 0
#endif
#ifndef STAG_WO
#define STAG_WO 0
#endif
#ifndef STAG_UP
#define STAG_UP 0
#endif
#ifndef STAG_DOWN
#define STAG_DOWN 0
#endif
#ifndef RES_BF16
#define RES_BF16 0
#endif
#define LAS __attribute__((address_space(3)))
#define GAS __attribute__((address_space(1)))
#define LDG(T, p) (*(const GAS T*)(p))
#define STG(T, p) (*(GAS T*)(p))
typedef unsigned short bf16_t;
typedef short bf16x8 __attribute__((ext_vector_type(8)));
typedef float f32x4 __attribute__((ext_vector_type(4)));
typedef float f32x2 __attribute__((ext_vector_type(2)));
typedef unsigned u32x4 __attribute__((ext_vector_type(4)));
typedef unsigned u32x2 __attribute__((ext_vector_type(2)));

constexpr int DM = 2048, TOKP = 8192, TOKS = 32768, TOK = TOKP + TOKS, DFF = 5504, NB = 12;
constexpr int SP_ = 2048, SS_ = 4096;
constexpr float EPS = 1e-6f, LOG2E = 1.4426950408889634f;
constexpr float QSCALE = 0.08838834764831845f * LOG2E;
constexpr float LAM_INIT2 = 0.47071301834358826f;
constexpr int NWAVES = 8, NTHREADS = 512;

constexpr size_t MiB = 1u << 20;
constexpr size_t WS_CTL = 0, CTL_ZERO_BYTES = 3 * MiB;
constexpr size_t WS_SSQ = 1 * MiB;
constexpr size_t WS_MOD = 3 * MiB;
constexpr size_t WS_LSE = 6 * MiB;
constexpr size_t WS_BIAS = 9 * MiB;
constexpr size_t WS_WT = 12 * MiB;
constexpr size_t LWT = 92798976;
constexpr size_t WT_QKV = 0, WT_WO = 16 * MiB, WT_UP = 24 * MiB, WT_DOWN = 67 * MiB;
constexpr size_t WS_H = 368 * MiB;
constexpr size_t WS_BIG = 532 * MiB;
constexpr size_t WS_H2 = 964 * MiB;
constexpr size_t WS_XB = 1128 * MiB;
constexpr size_t WS_END = 1292 * MiB;
constexpr int SSQ_STRIDE = TOK + 256, BIAS_L = 12 * (4096 + 2 * DFF);
static_assert(WS_SSQ + 8 * (size_t)SSQ_STRIDE * 4 <= WS_MOD && WS_BIAS + 4 * (size_t)BIAS_L * 4 <= WS_WT && WS_WT + 4 * LWT <= WS_H && WS_H + (size_t)(TOK + 512) * DM * 2 <= WS_BIG && WS_BIG + (size_t)TOK * DFF * 2 <= WS_H2 && WS_H2 + (size_t)TOK * DM * 2 <= WS_XB && WS_XB + (size_t)TOK * DM * 2 <= WS_END, "ws map");
constexpr size_t WS_KMAX = 65536;
constexpr size_t WS_ROPE = WS_KMAX + 4096;
constexpr size_t WS_CQ = WS_KMAX + 1024;
constexpr int CW_BAR = 4096;

constexpr int RING_BYTES = 131072, MISC_OFF = 139264, LDS_BYTES = 147456;

__device__ __forceinline__ unsigned cvt_pk_bf16(float lo, float hi) { unsigned r; asm volatile("v_cvt_pk_bf16_f32 %0, %1, %2" : "=v"(r) : "v"(lo), "v"(hi)); return r; }
__device__ __forceinline__ float bf_lo(unsigned w) { return __uint_as_float(w << 16); }
__device__ __forceinline__ float bf_hi(unsigned w) { return __uint_as_float(w & 0xffff0000u); }
template <int O> __device__ __forceinline__ float swz_xor(float v) { return __int_as_float(__builtin_amdgcn_ds_swizzle(__float_as_int(v), (O << 10) | 0x1F)); }
__device__ __forceinline__ float wave_sum(float v) {
    v += swz_xor<1>(v); v += swz_xor<2>(v); v += swz_xor<4>(v); v += swz_xor<8>(v); v += swz_xor<16>(v);
    auto rr = __builtin_amdgcn_permlane32_swap(__float_as_uint(v), __float_as_uint(v), false, false); return __uint_as_float(rr[0]) + __uint_as_float(rr[1]); }
__device__ __forceinline__ float wave_max(float v) {
    v = fmaxf(v, swz_xor<1>(v)); v = fmaxf(v, swz_xor<2>(v)); v = fmaxf(v, swz_xor<4>(v)); v = fmaxf(v, swz_xor<8>(v)); v = fmaxf(v, swz_xor<16>(v));
    auto rr = __builtin_amdgcn_permlane32_swap(__float_as_uint(v), __float_as_uint(v), false, false); return fmaxf(__uint_as_float(rr[0]), __uint_as_float(rr[1])); }
__device__ __forceinline__ float bperm(float v, int src_byte) { return __int_as_float(__builtin_amdgcn_ds_bpermute(src_byte, __float_as_int(v))); }
__device__ __forceinline__ int seq_len_of(int T) { return T < TOKP ? SP_ : SS_; }
__device__ __forceinline__ int batch_of(int T) { return T < TOKP ? (T >> 11) : 4 + ((T - TOKP) >> 12); }

__device__ __forceinline__ int lane_id() { int l; asm volatile("v_mbcnt_lo_u32_b32 %0, -1, 0\n\tv_mbcnt_hi_u32_b32 %0, -1, %0" : "=v"(l)); return l; }
#define XB_TMO      128
#define XB_XCNT(j)  (256  + 64 * (j))
#define XB_XSUB(j)  (1280 + 64 * (j))
#define XB_XGEN(j)  (2304 + 64 * (j))
#define XB_TOP      3328
#define XB_TOPGEN   3392
#define XCD_BAR_WORDS 3456
#define XB_SPIN_CAP (1u << 22)
__device__ __forceinline__ unsigned xb_ld(unsigned* p)              { return __hip_atomic_load(p, __ATOMIC_RELAXED, __HIP_MEMORY_SCOPE_AGENT); }
__device__ __forceinline__ unsigned xb_add(unsigned* p, unsigned v) { return __hip_atomic_fetch_add(p, v, __ATOMIC_RELAXED, __HIP_MEMORY_SCOPE_AGENT); }
__device__ __forceinline__ unsigned xb_xcc_id() { return (unsigned)__builtin_amdgcn_s_getreg((3 << 11) | 20) & 0xFu; }
#define XB_SPIN(cond, bar) do { unsigned _sp = 0; while (cond) { __builtin_amdgcn_s_sleep(1); \
    if ((++_sp & 255u) == 0u) { if (xb_ld(&(bar)[XB_TMO])) break; if (_sp > XB_SPIN_CAP) { atomicAdd(&(bar)[XB_TMO], 1u); break; } } } } while (0)
struct XcdBarrier { unsigned* bar; unsigned x; volatile LAS unsigned* st; unsigned w0; };
__device__ __forceinline__ XcdBarrier xcd_barrier_post(unsigned* bar, volatile LAS unsigned* st, unsigned w0) {
    XcdBarrier b; b.bar = bar; b.x = xb_xcc_id(); b.st = st; b.w0 = w0;
    if (w0 == 0u && lane_id() == 0) (void)xb_add(&bar[XB_XCNT(b.x)], 1u);
    return b;
}
__device__ __forceinline__ void xcd_barrier_complete(unsigned* bar, unsigned x, unsigned& nloc, unsigned& nx) {
    const unsigned G = gridDim.x * gridDim.y * gridDim.z;
    unsigned sum, cnt, mine, sp = 0u;
    for (;;) {
        sum = 0u; cnt = 0u; mine = 0u;
#pragma unroll
        for (unsigned j = 0; j < 16; ++j) { const unsigned c = xb_ld(&bar[XB_XCNT(j)]); sum += c; cnt += (c > 0u) ? 1u : 0u; mine = (j == x) ? c : mine; }
        if (sum == G) break;
        __builtin_amdgcn_s_sleep(1);
        if ((++sp & 255u) == 0u) { if (xb_ld(&bar[XB_TMO])) break; if (sp > XB_SPIN_CAP) { atomicAdd(&bar[XB_TMO], 1u); break; } }
    }
    nloc = mine > 0u ? mine : 1u; nx = cnt > 0u ? cnt : 1u;
}
__device__ __forceinline__ void xcd_barrier(const XcdBarrier& b) {
    asm volatile("s_waitcnt vmcnt(0)" ::: "memory");
    __syncthreads();
    if (b.w0 == 0u && lane_id() == 0) {
        unsigned* bar = b.bar;
        __builtin_amdgcn_s_waitcnt(0);
        unsigned nloc = b.st[0], nx = b.st[1];
        if (nloc == 0u) { xcd_barrier_complete(bar, b.x, nloc, nx); b.st[0] = nloc; b.st[1] = nx; }
        const unsigned old = xb_add(&bar[XB_XSUB(b.x)], 1u);
        const unsigned gen = old / nloc;
        if (old + 1u == (gen + 1u) * nloc) {
            __builtin_amdgcn_fence(__ATOMIC_RELEASE, "agent");
            asm volatile("s_waitcnt vmcnt(0)" ::: "memory");
            const unsigned og = xb_add(&bar[XB_TOP], 1u);
            const unsigned tg = og / nx;
            if (og + 1u == (tg + 1u) * nx) xb_add(&bar[XB_TOPGEN], 1u);
            else XB_SPIN(xb_ld(&bar[XB_TOPGEN]) == tg, bar);
            __builtin_amdgcn_fence(__ATOMIC_ACQUIRE, "agent");
            xb_add(&bar[XB_XGEN(b.x)], 1u);
            asm volatile("s_waitcnt vmcnt(0)" ::: "memory");
        } else {
            XB_SPIN(xb_ld(&bar[XB_XGEN(b.x)]) == gen, bar);
            __builtin_amdgcn_fence(__ATOMIC_ACQUIRE, "agent");
            asm volatile("s_waitcnt vmcnt(0)" ::: "memory");
        }
    }
    __syncthreads();
}

namespace pg8 {
constexpr int BM = 256, BK = 64, HALF = 128, HTB = HALF * BK * 2, STAGE_BYTES = 8 * HTB, NXCD = 8, WGM = 8;
__host__ __device__ __forceinline__ int lds_byte(int r, int c) { const int st = (r >> 4) * 2 + (c >> 5), rr = r & 15, cc = c & 31, ob = rr * 64 + cc * 2; return st * 1024 + (ob ^ (((ob >> 9) & 1) << 5)); }
__host__ __device__ __forceinline__ void stage_rc(int b, int& R, int& C) { const int st = b / 1024, sb = b % 1024, swz = sb ^ (((sb >> 9) & 1) << 5); R = (st >> 1) * 16 + swz / 64; C = (st & 1) * 32 + (swz % 64) / 2; }
__host__ __device__ __forceinline__ int perm32(int rho) { const int n = rho >> 4, i = rho & 15; return 8 * (i >> 2) + 4 * n + (i & 3); }
struct Unit { int pm, pn; };
struct Gemm { const bf16_t* A; const bf16_t* Bt; int K; };
struct StaticOrder {
    int nM, nN, nwg, G, c, wgm;
    __device__ void init(int nM_, int nN_, int G_, int c_, int wgm_ = WGM) { nM = nM_; nN = nN_; nwg = nM * nN; G = G_; c = c_; wgm = wgm_; }
    __device__ bool next(int i, Unit& u) const {
        const long L = (long)i * G + c; if (L >= nwg) return false;
        int wgid = (int)L; { const int q = nwg / NXCD, r = nwg % NXCD, xcd = wgid % NXCD, off = wgid / NXCD; wgid = (xcd < r ? xcd * (q + 1) : r * (q + 1) + (xcd - r) * q) + off; }
        const int nig = wgm * nN, gid = wgid / nig, fm = gid * wgm, gsz = (nM - fm) < wgm ? (nM - fm) : wgm;
        u.pm = fm + ((wgid % nig) % gsz); u.pn = (wgid % nig) / gsz; return true;
    }
};
template <class Epi, int AMODE>
__device__ __forceinline__ void gemm_phase(LAS unsigned char* lds, const Gemm g, const StaticOrder& S, const Epi& E, int stagger_us, int tid_in) {
    int tid = tid_in; asm volatile("" : "+v"(tid));
    const int wid = __builtin_amdgcn_readfirstlane(tid >> 6), lane = tid & 63, wr = wid >> 2, wc = wid & 3, fr = lane & 15, fq = lane >> 4;
    const int K = g.K, nt = K / BK;
    unsigned voffA[2], voffB[2];
#pragma unroll
    for (int i = 0; i < 2; ++i) { int R, C; stage_rc(tid * 16 + i * 8192, R, C); const int Rb = Epi::PERM ? ((R & ~31) + perm32(R & 31)) : R;
        const int Ra = AMODE == 1 ? (126 * (R >> 6) + 8 * (R & 15) + ((R >> 4) & 3)) : R;
        voffA[i] = (unsigned)(Ra * K + C) * 2u; voffB[i] = (unsigned)(Rb * K + C) * 2u; }
    const size_t kstep = (size_t)(BK * 2);
    const size_t hstepB = (size_t)HALF * K * 2, tstepB = 2 * hstepB;
    const size_t hstepA = AMODE == 1 ? (size_t)4 * K * 2 : hstepB, tstepA = AMODE == 1 ? (size_t)252 * K * 2 : tstepB;
    const char* Abase = (const char*)g.A - (AMODE == 1 ? (size_t)K * 2 : 0);
    const unsigned ldsw = (unsigned)wid * 1024u;
    const int aoff = lds_byte(wr * 64 + fr, fq * 8), boff = lds_byte(wc * 32 + fr, fq * 8);
#define PG8_SA(b, h) (((b) * 2 + (h)) * HTB)
#define PG8_SB(b, h) ((4 + (b) * 2 + (h)) * HTB)
#define PG8_STAGE(bufoff, gbase, voff) do { _Pragma("unroll") for (int _i = 0; _i < 2; ++_i) \
        __builtin_amdgcn_global_load_lds((const unsigned*)((const char*)(gbase) + (voff)[_i]), (LAS unsigned*)(lds + (bufoff) + ldsw + _i * 8192), 16, 0, 0); } while (0)
#define PG8_LDA(dst, b, h) do { _Pragma("unroll") for (int m = 0; m < 4; ++m) _Pragma("unroll") for (int k = 0; k < 2; ++k) dst[m][k] = *(const LAS bf16x8*)(lds + PG8_SA(b, h) + aoff + m * 2048 + k * 1024); } while (0)
#define PG8_LDB(dst, b, h) do { _Pragma("unroll") for (int n = 0; n < 2; ++n) _Pragma("unroll") for (int k = 0; k < 2; ++k) dst[n][k] = *(const LAS bf16x8*)(lds + PG8_SB(b, h) + boff + n * 2048 + k * 1024); } while (0)
#define PG8_MMA(ai, bj, At, Bt) do { __builtin_amdgcn_s_setprio(1); _Pragma("unroll") for (int m = 0; m < 4; ++m) _Pragma("unroll") for (int n = 0; n < 2; ++n) _Pragma("unroll") for (int k = 0; k < 2; ++k) \
        acc[ai][bj][m][n] = __builtin_amdgcn_mfma_f32_16x16x32_bf16(Bt[n][k], At[m][k], acc[ai][bj][m][n], 0, 0, 0); __builtin_amdgcn_s_setprio(0); } while (0)
#define PG8_WAIT_V(n) asm volatile("s_waitcnt vmcnt(" #n ")" ::: "memory")
#define PG8_WAIT_L(n) asm volatile("s_waitcnt lgkmcnt(" #n ")" ::: "memory")
#define PG8_BAR __builtin_amdgcn_s_barrier()
#define PG8_SCHED __builtin_amdgcn_sched_barrier(0)
    Unit cur, nxt; int ui = 0;
    if (!S.next(0, cur)) return;
    if (stagger_us > 0) { const unsigned long long ticks = (unsigned long long)(stagger_us * 100) * (unsigned)S.c / (unsigned)S.G, t0 = __builtin_amdgcn_s_memrealtime();
        while (__builtin_amdgcn_s_memrealtime() - t0 < ticks) __builtin_amdgcn_s_sleep(8); }
    f32x4 acc[2][2][4][2];
#pragma unroll
    for (int a = 0; a < 2; ++a)
#pragma unroll
        for (int b = 0; b < 2; ++b)
#pragma unroll
            for (int m = 0; m < 4; ++m)
#pragma unroll
                for (int n = 0; n < 2; ++n) acc[a][b][m][n] = (f32x4){0.f, 0.f, 0.f, 0.f};
    bf16x8 At[4][2], B0[2][2], B1[2][2];
    const char* cA = Abase + (size_t)cur.pm * tstepA; const char* cB = (const char*)g.Bt + (size_t)cur.pn * tstepB;
    PG8_STAGE(PG8_SB(0, 0), cB, voffB); PG8_STAGE(PG8_SB(0, 1), cB + hstepB, voffB); PG8_STAGE(PG8_SA(0, 0), cA, voffA); PG8_STAGE(PG8_SA(0, 1), cA + hstepA, voffA);
    if (wr == 1) PG8_BAR;
    PG8_WAIT_V(2); PG8_BAR;
    PG8_STAGE(PG8_SB(1, 0), cB + kstep, voffB); PG8_STAGE(PG8_SA(1, 0), cA + kstep, voffA); PG8_STAGE(PG8_SB(1, 1), cB + hstepB + kstep, voffB);
    PG8_WAIT_V(6); PG8_BAR;
    for (;;) {
        const bool has_next = S.next(ui + 1, nxt);
        const char* nA = has_next ? Abase + (size_t)nxt.pm * tstepA : cA; const char* nB = has_next ? (const char*)g.Bt + (size_t)nxt.pn * tstepB : cB;
        for (int t = 0; t < nt; t += 2) {
            const bool last = (t == nt - 2);
            const char* a1 = cA + (size_t)(t + 1) * kstep;
            const char* a2 = last ? nA : cA + (size_t)(t + 2) * kstep; const char* b2 = last ? nB : cB + (size_t)(t + 2) * kstep;
            const char* a3 = a2 + kstep; const char* b3 = b2 + kstep;
            PG8_LDB(B0, 0, 0); PG8_LDB(B1, 0, 1); PG8_SCHED; PG8_LDA(At, 0, 0); PG8_STAGE(PG8_SA(1, 1), a1 + hstepA, voffA);
            PG8_WAIT_V(8); PG8_WAIT_L(0); PG8_BAR; PG8_MMA(0, 0, At, B0); PG8_MMA(0, 1, At, B1); PG8_BAR; PG8_SCHED;
            PG8_LDA(At, 0, 1); PG8_STAGE(PG8_SB(0, 0), b2, voffB); PG8_STAGE(PG8_SB(0, 1), b2 + hstepB, voffB); PG8_STAGE(PG8_SA(0, 0), a2, voffA);
            PG8_WAIT_V(8); PG8_WAIT_L(0); PG8_BAR; PG8_MMA(1, 0, At, B0); PG8_MMA(1, 1, At, B1); PG8_BAR; PG8_SCHED;
            PG8_LDB(B0, 1, 0); PG8_LDB(B1, 1, 1); PG8_SCHED; PG8_LDA(At, 1, 0); PG8_STAGE(PG8_SA(0, 1), a2 + hstepA, voffA);
            PG8_WAIT_V(8); PG8_WAIT_L(0); PG8_BAR; PG8_MMA(0, 0, At, B0); PG8_MMA(0, 1, At, B1); PG8_BAR; PG8_SCHED;
            PG8_LDA(At, 1, 1); PG8_STAGE(PG8_SB(1, 0), b3, voffB); PG8_STAGE(PG8_SB(1, 1), b3 + hstepB, voffB); PG8_STAGE(PG8_SA(1, 0), a3, voffA);
            PG8_WAIT_V(8); PG8_WAIT_L(0); PG8_BAR; PG8_MMA(1, 0, At, B0); PG8_MMA(1, 1, At, B1); PG8_BAR; PG8_SCHED;
        }
        if (wr == 0) PG8_BAR;
        E(acc, cur, wr, wc, fr, fq);
        if (!has_next) break;
#pragma unroll
        for (int a = 0; a < 2; ++a)
#pragma unroll
            for (int b = 0; b < 2; ++b)
#pragma unroll
                for (int m = 0; m < 4; ++m)
#pragma unroll
                    for (int n = 0; n < 2; ++n) acc[a][b][m][n] = (f32x4){0.f, 0.f, 0.f, 0.f};
        cur = nxt; cA = nA; cB = nB; ++ui;
        if (wr == 1) PG8_BAR;
    }
    PG8_WAIT_V(0);
    PG8_BAR;
#undef PG8_SA
#undef PG8_SB
#undef PG8_STAGE
#undef PG8_LDA
#undef PG8_LDB
#undef PG8_MMA
#undef PG8_WAIT_V
#undef PG8_WAIT_L
#undef PG8_BAR
#undef PG8_SCHED
}

__device__ __forceinline__ f32x2 gelu_pk(f32x2 v) {
    const f32x2 av = __builtin_elementwise_abs(v), d = av * 0.2316418882f + 1.0f;
    f32x2 t; t.x = __builtin_amdgcn_rcpf(d.x); t.y = __builtin_amdgcn_rcpf(d.y);
    f32x2 q = t * 0.5307027145f + (-0.7265760135f); q = q * t + 0.7107068705f; q = q * t + (-0.142248368f); q = q * t + 0.127414796f; q = q * t;
    const f32x2 s = (v * v) * (-0.72134752044f);
    f32x2 e; e.x = __builtin_amdgcn_exp2f(s.x); e.y = __builtin_amdgcn_exp2f(s.y);
    const f32x2 h = 0.5f - q * e;
    return av * h + v * 0.5f;
}

__device__ __forceinline__ float rstd_of(const float* ssq, int row) { return 1.0f / sqrtf(LDG(float, ssq + row) * (1.f / DM) + EPS); }
struct EpiQKV {
    static constexpr bool PERM = true;
    bf16_t* O; int ldc; int qcols; float qscale; const float* ssq; const float* bias;
    __device__ __forceinline__ void operator()(const f32x4 (&acc)[2][2][4][2], const Unit& u, int wr, int wc, int fr, int fq) const {
        const int row0 = u.pm * BM + wr * 64 + fr; const int col0 = u.pn * BM + wc * 32 + 8 * fq;
        const float sc = (u.pn * BM < qcols) ? qscale : 1.f;
        const float* bp = bias + (size_t)batch_of(u.pm * BM) * ldc + col0;
        f32x4 bv[2][2]; float sq[8];
#pragma unroll
        for (int am = 0; am < 8; ++am) sq[am] = LDG(float, ssq + row0 + (am >> 2) * HALF + (am & 3) * 16);
#pragma unroll
        for (int bj = 0; bj < 2; ++bj)
#pragma unroll
            for (int n = 0; n < 2; ++n) bv[bj][n] = LDG(f32x4, bp + bj * HALF + 4 * n) * sc;
#pragma unroll
        for (int ai = 0; ai < 2; ++ai)
#pragma unroll
            for (int m = 0; m < 4; ++m) { const int row = row0 + ai * HALF + m * 16; const float rs = __builtin_amdgcn_rsqf(sq[ai * 4 + m] * (1.f / DM) + EPS) * sc; bf16_t* rowp = O + (size_t)row * ldc + col0;
#pragma unroll
                for (int bj = 0; bj < 2; ++bj) { const f32x4 v0 = acc[ai][bj][m][0] * rs + bv[bj][0], v1 = acc[ai][bj][m][1] * rs + bv[bj][1];
                    u32x4 w; w.x = cvt_pk_bf16(v0[0], v0[1]); w.y = cvt_pk_bf16(v0[2], v0[3]); w.z = cvt_pk_bf16(v1[0], v1[1]); w.w = cvt_pk_bf16(v1[2], v1[3]);
                    STG(u32x4, rowp + bj * HALF) = w; } }
    }
};
template <bool NEXT> struct EpiRes {
    static constexpr bool PERM = false;
    const float* base_p; const float* base_s;
    float* out; const float* gate;
    bf16_t* xres;
    bf16_t* xg; const float* gain; const float* scale; float* ssq;
    __device__ __forceinline__ void operator()(const f32x4 (&acc)[2][2][4][2], const Unit& u, int wr, int wc, int fr, int fq) const {
        const int row0 = u.pm * BM + wr * 64 + fr, col0 = u.pn * BM + wc * 32 + 4 * fq;
        const float* base = (u.pm * BM < TOKP) ? base_p : base_s;
        const int b = batch_of(u.pm * BM);
        const float* gp = gate + (size_t)b * (6 * DM) + col0;
        f32x4 gv[2][2], gg[2][2], gs[2][2];
#pragma unroll
        for (int bj = 0; bj < 2; ++bj)
#pragma unroll
            for (int n = 0; n < 2; ++n) { gv[bj][n] = LDG(f32x4, gp + bj * HALF + n * 16);
                if (NEXT) { gg[bj][n] = LDG(f32x4, gain + col0 + bj * HALF + n * 16); gs[bj][n] = LDG(f32x4, scale + (size_t)b * (6 * DM) + col0 + bj * HALF + n * 16); } }
        f32x4 bs0[2][2][2];
#pragma unroll
        for (int mm = 0; mm < 2; ++mm)
#pragma unroll
            for (int bj = 0; bj < 2; ++bj)
#pragma unroll
                for (int n = 0; n < 2; ++n) { const size_t o_ = (size_t)(row0 + mm * 16) * DM + col0 + bj * HALF + n * 16;
                    if (RES_BF16) { const u32x2 r = LDG(u32x2, xres + o_); bs0[mm][bj][n] = (f32x4){bf_lo(r.x), bf_hi(r.x), bf_lo(r.y), bf_hi(r.y)}; }
                    else bs0[mm][bj][n] = LDG(f32x4, base + o_); }
        asm volatile("" ::: "memory");
        if (NEXT) {
#pragma unroll
            for (int bj = 0; bj < 2; ++bj)
#pragma unroll
                for (int n = 0; n < 2; ++n) gg[bj][n] = gg[bj][n] * (gs[bj][n] + 1.0f); }
#pragma unroll
        for (int ai = 0; ai < 2; ++ai)
#pragma unroll
        for (int mp = 0; mp < 2; ++mp) {
            f32x4 bs[2][2][2];
#pragma unroll
            for (int mm = 0; mm < 2; ++mm)
#pragma unroll
                for (int bj = 0; bj < 2; ++bj)
#pragma unroll
                    for (int n = 0; n < 2; ++n) { const size_t o_ = (size_t)(row0 + ai * HALF + (2 * mp + mm) * 16) * DM + col0 + bj * HALF + n * 16;
                        if (ai == 0 && mp == 0) bs[mm][bj][n] = bs0[mm][bj][n];
                        else if (RES_BF16) { const u32x2 r = LDG(u32x2, xres + o_); bs[mm][bj][n] = (f32x4){bf_lo(r.x), bf_hi(r.x), bf_lo(r.y), bf_hi(r.y)}; }
                        else bs[mm][bj][n] = LDG(f32x4, base + o_); }
            asm volatile("" ::: "memory");
#pragma unroll
            for (int mm = 0; mm < 2; ++mm) { const int m = 2 * mp + mm; const int row = row0 + ai * HALF + m * 16; const size_t off = (size_t)row * DM + col0; float ss = 0.f;
#pragma unroll
                for (int bj = 0; bj < 2; ++bj)
#pragma unroll
                    for (int n = 0; n < 2; ++n) { const f32x4 xn = bs[mm][bj][n] + gv[bj][n] * acc[ai][bj][m][n];
                        if (RES_BF16) { u32x2 w_; w_.x = cvt_pk_bf16(xn[0], xn[1]); w_.y = cvt_pk_bf16(xn[2], xn[3]); STG(u32x2, xres + off + bj * HALF + n * 16) = w_; }
                        else STG(f32x4, out + off + bj * HALF + n * 16) = xn;
                        if (NEXT) { ss += (xn[0] * xn[0] + xn[1] * xn[1]) + (xn[2] * xn[2] + xn[3] * xn[3]); const f32x4 y = xn * gg[bj][n];
                            u32x2 w; w.x = cvt_pk_bf16(y[0], y[1]); w.y = cvt_pk_bf16(y[2], y[3]); STG(u32x2, xg + off + bj * HALF + n * 16) = w; } }
                if (NEXT) { ss += swz_xor<16>(ss); auto rr = __builtin_amdgcn_permlane32_swap(__float_as_uint(ss), __float_as_uint(ss), false, false); ss = __uint_as_float(rr[0]) + __uint_as_float(rr[1]);
                    if (fq == 0) atomicAdd(ssq + row, ss); } }
            asm volatile("" ::: "memory");
        }
    }
};
struct EpiNull {
    static constexpr bool PERM = true;
    __device__ __forceinline__ void operator()(f32x4 (&acc)[2][2][4][2], const Unit&, int, int, int, int) const {
#pragma unroll
        for (int ai = 0; ai < 2; ++ai)
#pragma unroll
            for (int m = 0; m < 4; ++m) asm volatile("" :: "v"(acc[ai][0][m][0]), "v"(acc[ai][0][m][1]), "v"(acc[ai][1][m][0]), "v"(acc[ai][1][m][1]));
    }
};
struct EpiGLU {
    static constexpr bool PERM = true;
    bf16_t* G; const float* cw; const float* cb; const float* ssq; const float* bias;
    __device__ __forceinline__ void operator()(f32x4 (&acc)[2][2][4][2], const Unit& u, int wr, int wc, int fr, int fq) const {
        const int lane = (fq << 4) | fr;
        const int f0 = 128 * u.pn + 32 * wc + 8 * fq;
        const int tok0 = 252 * u.pm + 126 * wr - 1;
        {
            const int tq = tok0 + 8 * fr; const int tA = tq < 0 ? 0 : (tq > TOK - 1 ? TOK - 1 : tq), tB = (tq + 7) > TOK - 1 ? TOK - 1 : (tq + 7);
            const int bA = batch_of(tA), bB = batch_of(tB); const bool same = __all(bA == bB);
            const float* bp0 = bias + 256 * u.pn + 32 * wc + 8 * fq;
            f32x4 bvA[2][2]; float sq[8];
#pragma unroll
            for (int am = 0; am < 8; ++am) { int tok = tq + am; tok = tok < 0 ? 0 : (tok > TOK - 1 ? TOK - 1 : tok); sq[am] = LDG(float, ssq + tok); }
#pragma unroll
            for (int bj = 0; bj < 2; ++bj)
#pragma unroll
                for (int n = 0; n < 2; ++n) bvA[bj][n] = LDG(f32x4, bp0 + (size_t)bA * (2 * DFF) + bj * HALF + 4 * n);
#pragma unroll
            for (int am = 0; am < 8; ++am) { const int ai = am >> 2, m = am & 3;
                const float rs = __builtin_amdgcn_rsqf(sq[am] * (1.f / DM) + EPS);
#pragma unroll
                for (int bj = 0; bj < 2; ++bj)
#pragma unroll
                    for (int n = 0; n < 2; ++n) acc[ai][bj][m][n] = acc[ai][bj][m][n] * rs + bvA[bj][n];
                asm volatile("" : "+v"(acc[ai][0][m][0]), "+v"(acc[ai][0][m][1]), "+v"(acc[ai][1][m][0]), "+v"(acc[ai][1][m][1])); }
            if (!same) {
                asm volatile("" ::: "memory");
                f32x4 dv[2][2];
#pragma unroll
                for (int bj = 0; bj < 2; ++bj)
#pragma unroll
                    for (int n = 0; n < 2; ++n) dv[bj][n] = LDG(f32x4, bp0 + (size_t)bB * (2 * DFF) + bj * HALF + 4 * n) - bvA[bj][n];
#pragma unroll
                for (int am = 0; am < 8; ++am) { const int ai = am >> 2, m = am & 3; int tok = tq + am; tok = tok < 0 ? 0 : (tok > TOK - 1 ? TOK - 1 : tok);
                    const float mB = (batch_of(tok) == bA) ? 0.f : 1.f;
#pragma unroll
                    for (int bj = 0; bj < 2; ++bj)
#pragma unroll
                        for (int n = 0; n < 2; ++n) acc[ai][bj][m][n] += dv[bj][n] * mB; } } }
        f32x4 w0[2], w1[2], w2[2], cbv[2];
#pragma unroll
        for (int n = 0; n < 2; ++n) { w0[n] = LDG(f32x4, cw + f0 + 4 * n); w1[n] = LDG(f32x4, cw + DFF + f0 + 4 * n); w2[n] = LDG(f32x4, cw + 2 * DFF + f0 + 4 * n); cbv[n] = LDG(f32x4, cb + f0 + 4 * n); }
        const int srcR = ((lane & 48) | ((fr + 15) & 15)) << 2, srcL = ((lane & 48) | ((fr + 1) & 15)) << 2;
        f32x4 pvx[2], nvx[2];
#pragma unroll
        for (int n = 0; n < 2; ++n)
#pragma unroll
            for (int e = 0; e < 4; ++e) { pvx[n][e] = bperm(acc[1][0][3][n][e], srcR); nvx[n][e] = bperm(acc[0][0][0][n][e], srcL); }
        const int tokl = tok0 + 8 * fr;
        const int S = seq_len_of(tokl < 0 ? 0 : tokl);
#pragma unroll
        for (int am = 0; am < 8; ++am) {
            const int ai = am >> 2, m = am & 3;
            const int j = 8 * fr + am, tok = tokl + am, tpos = tok & (S - 1);
            const bool first = (tpos == 0), lastt = (tpos == S - 1); const bool edge = __any(first || lastt);
            const bool ok = (j >= 1) && (j <= 126) && (tok < TOK);
            u32x4 w;
#pragma unroll
            for (int n = 0; n < 2; ++n) {
                f32x4 pv = (am == 0) ? pvx[n] : acc[(am - 1 < 0 ? 0 : am - 1) >> 2][0][(am - 1 < 0 ? 0 : am - 1) & 3][n];
                f32x4 nv = (am == 7) ? nvx[n] : acc[(am + 1 > 7 ? 7 : am + 1) >> 2][0][(am + 1 > 7 ? 7 : am + 1) & 3][n];
                f32x4 v = cbv[n] + w0[n] * pv + w1[n] * acc[ai][0][m][n] + w2[n] * nv;
                if (edge) {
                    asm volatile("" ::: "memory");
                    const f32x4 z = {0.f, 0.f, 0.f, 0.f}; const f32x4 pz = first ? z : pv, nz = lastt ? z : nv;
                    v = cbv[n] + w0[n] * pz + w1[n] * acc[ai][0][m][n] + w2[n] * nz; }
                const f32x2 g0 = gelu_pk((f32x2){v[0], v[1]}), g1 = gelu_pk((f32x2){v[2], v[3]});
                const f32x4 bb = acc[ai][1][m][n];
                const unsigned lo = cvt_pk_bf16(g0.x * bb[0], g0.y * bb[1]), hi = cvt_pk_bf16(g1.x * bb[2], g1.y * bb[3]);
                if (n == 0) { w.x = lo; w.y = hi; } else { w.z = lo; w.w = hi; }
            }
            if (ok) STG(u32x4, G + (size_t)tok * DFF + f0) = w;
        }
    }
};
}

struct Args { const float* in[26]; float* out; unsigned char* ws; int ph_lo, ph_hi; };
struct Frame {
    LAS unsigned char* lds; int tid, lane, wave, vcu, G, gw, NGW;
    unsigned long long kargs; float* out; unsigned char* ws;
    bf16_t* hbuf; bf16_t* hbuf2; bf16_t* big; float* mod; float* lse; float* ssq; float* bias; bf16_t* xb;
};
__device__ __forceinline__ Frame fresh(const Frame& F0) { Frame F = F0;
    asm volatile("" : "+v"(F.tid), "+v"(F.lane), "+s"(F.wave), "+s"(F.vcu), "+s"(F.G), "+s"(F.gw), "+s"(F.NGW), "+s"(F.kargs));
    asm volatile("" : "+s"(F.out), "+s"(F.ws), "+s"(F.hbuf), "+s"(F.big), "+s"(F.mod), "+s"(F.lse)); asm volatile("" : "+s"(F.hbuf2), "+s"(F.ssq), "+s"(F.bias), "+s"(F.xb)); return F; }
__device__ __forceinline__ const float* argp(const Frame& F, int idx) { unsigned long long p = F.kargs; asm volatile("" : "+s"(p)); return ((const float* const __attribute__((address_space(4)))*)p)[idx]; }
__device__ __forceinline__ bf16_t* wt_ptr(const Frame& F, int layer, size_t off) { return (bf16_t*)(F.ws + WS_WT + (size_t)layer * LWT + off); }

__device__ __forceinline__ void transpose_item(const float* W, int K, int N, bf16_t* WT, int dest_row0, int k0, int n0, LAS float* scr, int lane) {
    float wv[32];
#pragma unroll
    for (int i = 0; i < 32; ++i) { const int kk = 2 * i + (lane >> 5); wv[i] = LDG(float, W + (size_t)(k0 + kk) * N + n0 + (lane & 31)); }
#pragma unroll
    for (int i = 0; i < 32; ++i) { const int kk = 2 * i + (lane >> 5); scr[kk * 33 + (lane & 31)] = wv[i]; }
    asm volatile("s_waitcnt lgkmcnt(0)" ::: "memory");
    const int c = lane & 7;
#pragma unroll
    for (int j = 0; j < 4; ++j) { const int n = (lane >> 3) + 8 * j; const LAS float* s = scr + (8 * c) * 33 + n;
        u32x4 o; o.x = cvt_pk_bf16(s[0 * 33], s[1 * 33]); o.y = cvt_pk_bf16(s[2 * 33], s[3 * 33]); o.z = cvt_pk_bf16(s[4 * 33], s[5 * 33]); o.w = cvt_pk_bf16(s[6 * 33], s[7 * 33]);
        STG(u32x4, WT + (size_t)(dest_row0 + n) * K + k0 + 8 * c) = o; }
    asm volatile("s_waitcnt lgkmcnt(0)" ::: "memory");
}
__device__ __forceinline__ void phase_weights(const Frame& F0, int lmask, int cu0, int ncu) {
    const Frame F = fresh(F0);
    LAS float* scr = (LAS float*)(F.lds + F.wave * 16384);
    const int gw_ = ncu ? ((int)blockIdx.x - cu0) * NWAVES + F.wave : F.gw, ngw_ = ncu ? ncu * NWAVES : F.NGW;
    for (int layer = 0; layer < 4; ++layer) {
        if (!((lmask >> layer) & 1)) continue;
        const int NQ = (layer == 2) ? 4096 : 3072;
        const float* wqkv = argp(F, layer == 0 ? 8 : layer == 1 ? 12 : layer == 2 ? 15 : 19);
        const float* wo = argp(F, layer == 0 ? 11 : layer == 1 ? 14 : layer == 2 ? 18 : 20);
        const float* wup = argp(F, 21) + (size_t)layer * DM * 2 * DFF;
        const float* wdn = argp(F, 24) + (size_t)layer * DFF * DM;
        const int I_Q = 32 * (NQ / 32), I_O = 32 * (DM / 32), I_U = 32 * (2 * DFF / 32), I_D = (DFF / 64) * (DM / 32);
        const int NIT = I_Q + I_O + I_U + I_D;
        for (int it = gw_; it < NIT; it += ngw_) {
            int r = it;
            if (r < I_Q) { const int nblk = NQ / 32, kb = r / nblk, nb = r % nblk; transpose_item(wqkv, DM, NQ, wt_ptr(F, layer, WT_QKV), 32 * nb, 64 * kb, 32 * nb, scr, F.lane); continue; } r -= I_Q;
            if (r < I_O) { const int nblk = DM / 32, kb = r / nblk, nb = r % nblk; transpose_item(wo, DM, DM, wt_ptr(F, layer, WT_WO), 32 * nb, 64 * kb, 32 * nb, scr, F.lane); continue; } r -= I_O;
            if (r < I_U) { const int nblk = 2 * DFF / 32, kb = r / nblk, nb = r % nblk; const int n0 = 32 * nb; const int half = n0 >= DFF ? 1 : 0, nn = n0 - half * DFF;
                const int drow = (nn >> 7) * 256 + half * 128 + (nn & 127);
                transpose_item(wup, DM, 2 * DFF, wt_ptr(F, layer, WT_UP), drow, 64 * kb, n0, scr, F.lane); continue; } r -= I_U;
            { const int nblk = DM / 32, kb = r / nblk, nb = r % nblk; transpose_item(wdn, DFF, DM, wt_ptr(F, layer, WT_DOWN), 32 * nb, 64 * kb, 32 * nb, scr, F.lane); }
        }
    }
}
__device__ __forceinline__ void phase_mod(const Frame& F0) {
    const Frame F = fresh(F0);
    LAS float* sl = (LAS float*)F.lds;
    LAS float* red = (LAS float*)(F.lds + 98304);
    { const float* cp = argp(F, 2); const float* cs = argp(F, 3); float cv[48];
#pragma unroll
      for (int r = 0; r < 48; ++r) { const int i = F.tid + r * NTHREADS, bb = i >> 11, d = i & 2047; cv[r] = bb < 4 ? LDG(float, cp + bb * DM + d) : LDG(float, cs + (bb - 4) * DM + d); }
#pragma unroll
      for (int r = 0; r < 48; ++r) { const int i = F.tid + r * NTHREADS, bb = i >> 11, d = i & 2047; const float c = cv[r]; sl[d * NB + bb] = c / (1.f + __expf(-c)); } }
    __syncthreads();
    const int col = F.tid & 63, kg = F.tid >> 6;
    for (int unit = F.vcu; unit < 4 * 192; unit += F.G) {
        const int l = unit / 192, n0 = (unit % 192) * 64;
        const float* w = argp(F, 6) + (size_t)l * DM * (6 * DM) + n0 + col;
        float acc[NB];
#pragma unroll
        for (int b = 0; b < NB; ++b) acc[b] = 0.f;
        for (int d0 = kg * 256; d0 < kg * 256 + 256; d0 += 32) {
            float wvv[32];
#pragma unroll
            for (int i = 0; i < 32; ++i) wvv[i] = LDG(float, w + (size_t)(d0 + i) * (6 * DM));
#pragma unroll
            for (int i = 0; i < 32; ++i) { const int d = d0 + i; const float wv = wvv[i];
                const f32x4 s0 = *(const LAS f32x4*)(sl + d * NB), s1 = *(const LAS f32x4*)(sl + d * NB + 4), s2 = *(const LAS f32x4*)(sl + d * NB + 8);
                acc[0] += wv * s0[0]; acc[1] += wv * s0[1]; acc[2] += wv * s0[2]; acc[3] += wv * s0[3];
                acc[4] += wv * s1[0]; acc[5] += wv * s1[1]; acc[6] += wv * s1[2]; acc[7] += wv * s1[3];
                acc[8] += wv * s2[0]; acc[9] += wv * s2[1]; acc[10] += wv * s2[2]; acc[11] += wv * s2[3]; } }
#pragma unroll
        for (int b = 0; b < NB; ++b) red[(kg * NB + b) * 64 + col] = acc[b];
        __syncthreads();
        for (int o = F.tid; o < NB * 64; o += NTHREADS) { const int b = o >> 6, c2 = o & 63; float s = 0.f;
#pragma unroll
            for (int k = 0; k < 8; ++k) s += red[(k * NB + b) * 64 + c2];
            F.mod[((size_t)l * NB + b) * (6 * DM) + n0 + c2] = s + argp(F, 7)[(size_t)l * 6 * DM + n0 + c2]; }
        __syncthreads();
    }
}
__device__ __forceinline__ void phase_norm0(const Frame& F0, const float* xp, const float* xs, const float* gain, const float* modl, int sc_chunk, float* ssq) {
    const Frame F = fresh(F0);
    for (int row = F.gw; row < TOK; row += F.NGW) {
        const float* xr = (row < TOKP ? xp : xs) + (size_t)row * DM;
        const float* mb = modl + (size_t)batch_of(row) * (6 * DM);
        float ss = 0.f; bf16_t* orow = F.hbuf + (size_t)row * DM;
        f32x4 v[8], gn[8], sc[8];
#pragma unroll
        for (int j = 0; j < 8; ++j) { const int c = 4 * (F.lane + 64 * j); v[j] = LDG(f32x4, xr + c); gn[j] = LDG(f32x4, gain + c); sc[j] = LDG(f32x4, mb + sc_chunk * DM + c); }
        asm volatile("" ::: "memory");
#pragma unroll
        for (int j = 0; j < 8; ++j) { const int c = 4 * (F.lane + 64 * j); ss += (v[j][0] * v[j][0] + v[j][1] * v[j][1]) + (v[j][2] * v[j][2] + v[j][3] * v[j][3]);
            const f32x4 y = v[j] * gn[j] * (sc[j] + 1.0f);
            u32x2 w; w.x = cvt_pk_bf16(y[0], y[1]); w.y = cvt_pk_bf16(y[2], y[3]); STG(u32x2, orow + c) = w;
            if (RES_BF16) { u32x2 wx; wx.x = cvt_pk_bf16(v[j][0], v[j][1]); wx.y = cvt_pk_bf16(v[j][2], v[j][3]); STG(u32x2, F.xb + (size_t)row * DM + c) = wx; } }
        ss = wave_sum(ss);
        if (F.lane == 0) STG(float, ssq + row) = ss;
    }
}
__device__ __forceinline__ void phase_bias(const Frame& F0, int lmask, int cu0, int ncu) {
    const Frame F = fresh(F0);
    LAS bf16_t* sh = (LAS bf16_t*)F.lds;
    const int fr = F.lane & 15, fq = F.lane >> 4;
    const int gw_ = ncu ? ((int)blockIdx.x - cu0) * NWAVES + F.wave : F.gw, ngw_ = ncu ? ncu * NWAVES : F.NGW;
    for (int l = 0; l < 4; ++l) {
        if (!((lmask >> l) & 1)) continue;
        const int NQ = (l == 2) ? 4096 : 3072;
#pragma unroll 1
        for (int part = 0; part < 2; ++part) {
            __syncthreads();
            {
                f32x2 mv[2 * NB];
#pragma unroll
                for (int r = 0; r < 2 * NB; ++r) { const int i = F.tid + r * NTHREADS, bb = i >> 10, d = 2 * (i & 1023);
                    mv[r] = LDG(f32x2, F.mod + ((size_t)l * NB + bb) * (6 * DM) + (part ? 3 : 0) * DM + d); }
#pragma unroll
                for (int r = 0; r < 2 * NB; ++r) ((LAS unsigned*)sh)[F.tid + r * NTHREADS] = cvt_pk_bf16(mv[r][0], mv[r][1]);
#pragma unroll
                for (int r = 2 * NB; r < 32; ++r) ((LAS unsigned*)sh)[F.tid + r * NTHREADS] = 0u; }
            __syncthreads();
            const int N = part ? 2 * DFF : NQ; const bf16_t* Wt = wt_ptr(F, l, part ? WT_UP : WT_QKV); float* bo = F.bias + (size_t)l * BIAS_L + (part ? 12 * 4096 : 0);
            for (int n0 = 16 * gw_; n0 < N; n0 += 16 * ngw_) {
                f32x4 acc = {0.f, 0.f, 0.f, 0.f};
                const bf16_t* wp = Wt + (size_t)(n0 + fr) * DM + 8 * fq; const LAS bf16_t* sp = sh + fr * DM + 8 * fq;
#pragma unroll 1
                for (int k0 = 0; k0 < DM; k0 += 256) {
                    bf16x8 wv[8];
#pragma unroll
                    for (int j = 0; j < 8; ++j) wv[j] = LDG(bf16x8, wp + k0 + 32 * j);
#pragma unroll
                    for (int j = 0; j < 8; ++j) acc = __builtin_amdgcn_mfma_f32_16x16x32_bf16(wv[j], *(const LAS bf16x8*)(sp + k0 + 32 * j), acc, 0, 0, 0);
                }
                if (fr < NB) STG(f32x4, bo + (size_t)fr * N + n0 + 4 * fq) = acc;
            }
        }
    }
}
__device__ __forceinline__ void phase_final_norm(const Frame& F0, const float* gain) {
    const Frame F = fresh(F0);
    for (int row = F.gw; row < TOK; row += F.NGW) {
        float* xr = F.out + (size_t)row * DM;
        f32x4 v[8]; float ss = 0.f;
#pragma unroll
        for (int j = 0; j < 8; ++j) { const int c = 4 * (F.lane + 64 * j);
            if (RES_BF16) { const u32x2 r = LDG(u32x2, F.xb + (size_t)row * DM + c); v[j] = (f32x4){bf_lo(r.x), bf_hi(r.x), bf_lo(r.y), bf_hi(r.y)}; } else v[j] = LDG(f32x4, xr + c);
            ss += (v[j][0] * v[j][0] + v[j][1] * v[j][1]) + (v[j][2] * v[j][2] + v[j][3] * v[j][3]); }
        const float rstd = 1.0f / sqrtf(wave_sum(ss) * (1.f / DM) + EPS);
#pragma unroll
        for (int j = 0; j < 8; ++j) { const int c = 4 * (F.lane + 64 * j); const f32x4 g = LDG(f32x4, gain + c); STG(f32x4, xr + c) = (v[j] * rstd) * g; }
    }
}
__device__ __forceinline__ void phase_ropetab(const Frame& F0) {
    const Frame F = fresh(F0);
    float* tab = (float*)(F.ws + WS_ROPE);
    for (int i = F.gw * 64 + F.lane; i < 64 * 32; i += F.NGW * 64) { const int f = i & 31; const float invf = exp2f(-(float)f * (13.287712379549449f / 32.f));
        float sn, cs; sincosf((float)(i >> 5) * invf, &sn, &cs); STG(f32x2, tab + 2 * i) = (f32x2){cs, sn}; }
}
template <bool QFOLD>
__device__ __forceinline__ void phase_qknorm_rope(const Frame& F0, const float* qn, const float* kn) {
    const Frame F = fresh(F0);
    const int k16 = F.lane & 15, grp = F.lane >> 4;
    for (int T = F.gw; T < TOK; T += F.NGW) {
        const int S = seq_len_of(T), t = T & (S - 1);
        const float posv = (k16 & 8) ? (float)(t & 63) : (float)(t >> 6);
        float cs[8], sn[8];
#pragma unroll
        for (int e = 0; e < 8; ++e) { const int f = 8 * (k16 & 3) + e; const float invf = exp2f(-(float)f * (13.287712379549449f / 32.f)); sincosf(posv * invf, &sn[e], &cs[e]); }
        const float sgn = (k16 & 4) ? 1.f : -1.f;
        bf16_t* rowp = F.big + (size_t)T * 3072;
        u32x4 raws[5];
#pragma unroll
        for (int it = QFOLD ? 4 : 0; it < 5; ++it) raws[it] = LDG(u32x4, rowp + (it * 4 + grp) * 128 + 8 * k16);
        asm volatile("" ::: "memory");
#pragma unroll
        for (int it = QFOLD ? 4 : 0; it < 5; ++it) {
            const int head = it * 4 + grp;
            bf16_t* p = rowp + head * 128 + 8 * k16;
            const u32x4 raw = raws[it];
            float x[8] = {bf_lo(raw.x), bf_hi(raw.x), bf_lo(raw.y), bf_hi(raw.y), bf_lo(raw.z), bf_hi(raw.z), bf_lo(raw.w), bf_hi(raw.w)};
            float ss = 0.f;
#pragma unroll
            for (int e = 0; e < 8; ++e) ss += x[e] * x[e];
            ss += swz_xor<1>(ss); ss += swz_xor<2>(ss); ss += swz_xor<4>(ss); ss += swz_xor<8>(ss);
            const float rstd = 1.0f / sqrtf(ss * (1.f / 128.f) + EPS);
            const float* gsrc = (head < 16 ? qn : kn) + 8 * k16;
            const float osc = head < 16 ? QSCALE : 1.f;
            float y[8], o[8];
#pragma unroll
            for (int e = 0; e < 8; ++e) y[e] = x[e] * rstd * gsrc[e];
#pragma unroll
            for (int e = 0; e < 8; ++e) { const float partner = swz_xor<4>(y[e]); o[e] = (y[e] * cs[e] + sgn * partner * sn[e]) * osc; }
            u32x4 w; w.x = cvt_pk_bf16(o[0], o[1]); w.y = cvt_pk_bf16(o[2], o[3]); w.z = cvt_pk_bf16(o[4], o[5]); w.w = cvt_pk_bf16(o[6], o[7]);
            STG(u32x4, p) = w;
        }
    }
}

__device__ __forceinline__ void q_to_lds(LAS float* qs, const bf16_t* q, int lane) { const unsigned w = *(const unsigned*)(q + 2 * lane); qs[2 * lane] = bf_lo(w); qs[2 * lane + 1] = bf_hi(w); }
__device__ __forceinline__ float qk_dot(const LAS float* qs, const bf16_t* krow) {
    float s = 0.f;
#pragma unroll
    for (int i = 0; i < 16; ++i) { const u32x4 kv = *(const u32x4*)(krow + 8 * i); const f32x4 qa = *(const LAS f32x4*)(qs + 8 * i), qb = *(const LAS f32x4*)(qs + 8 * i + 4);
        s += qa[0] * bf_lo(kv.x) + qa[1] * bf_hi(kv.x) + qa[2] * bf_lo(kv.y) + qa[3] * bf_hi(kv.y) + qb[0] * bf_lo(kv.z) + qb[1] * bf_hi(kv.z) + qb[2] * bf_lo(kv.w) + qb[3] * bf_hi(kv.w); }
    return s;
}
template <int NV> struct OSt { float m, l; float o[NV / 64]; };
template <int NV> __device__ __forceinline__ void attn_chunk(OSt<NV>& st, float s, int voff, const bf16_t* base, int lane) {
    const float cm = wave_max(s);
    if (cm == -INFINITY) return;
    const float mn = fmaxf(st.m, cm), alpha = __builtin_amdgcn_exp2f(st.m - mn), p = __builtin_amdgcn_exp2f(s - mn);
    st.l = st.l * alpha + wave_sum(p); st.m = mn;
#pragma unroll
    for (int k = 0; k < NV / 64; ++k) st.o[k] *= alpha;
    for (int jj = 0; jj < 64; ++jj) {
        const float pj = __uint_as_float(__builtin_amdgcn_readlane(__float_as_uint(p), jj));
        if (pj != 0.f) { const int off = __builtin_amdgcn_readlane(voff, jj);
            if (NV == 128) { const unsigned w = *(const unsigned*)(base + off + 2 * lane); st.o[0] += pj * bf_lo(w); st.o[1] += pj * bf_hi(w); }
            else { const u32x2 w = *(const u32x2*)(base + off + 4 * lane); st.o[0] += pj * bf_lo(w.x); st.o[1] += pj * bf_hi(w.x); st.o[2] += pj * bf_lo(w.y); st.o[3] += pj * bf_hi(w.y); } }
    }
}
template <int MIX> __device__ __forceinline__ void phase_attn_naive(const Frame& F0) {
    const Frame F = fresh(F0);
    LAS float* qs = (LAS float*)(F.lds + F.wave * 1024);
    const int NH = (MIX == 2) ? 8 : 16, W = (MIX == 2) ? 4096 : 3072;
    const bf16_t* qkv = F.big;
    for (int job = F.gw; job < TOK * NH; job += F.NGW) {
        const int T = job / NH, h = job % NH, S = seq_len_of(T), sb = T & ~(S - 1), t = T - sb;
        if (MIX != 2) {
            const int kvh = h >> 2, kcol = 2048 + kvh * 128, vcol = 2560 + kvh * 128;
            q_to_lds(qs, qkv + (size_t)T * W + h * 128, F.lane);
            asm volatile("s_waitcnt lgkmcnt(0)" ::: "memory");
            OSt<128> st; st.m = -1e30f; st.l = 0.f; st.o[0] = 0.f; st.o[1] = 0.f;
            const float slope2 = exp2f(-0.5f * (float)(h + 1)) * LOG2E;
            if (MIX == 0) {
                for (int c = 0; c < S / 64; ++c) { const int pos = 64 * c + F.lane; const int ro = (sb + pos) * W;
                    const float s = qk_dot(qs, qkv + ro + kcol); attn_chunk<128>(st, s, ro + vcol, qkv, F.lane); }
            } else if (MIX == 1) {
                st.m = argp(F, 13)[h] * LOG2E; st.l = 1.f;
                for (int c = 0; c < 5; ++c) { const int pos = t - 128 + 64 * c + F.lane; const int d = pos - t; const bool valid = (d >= -128) && (d <= 128) && (pos >= 0) && (pos < S);
                    const int pc = pos < 0 ? 0 : (pos > S - 1 ? S - 1 : pos); const int ro = (sb + pc) * W;
                    float s = qk_dot(qs, qkv + ro + kcol) - slope2 * fabsf((float)d); s = valid ? s : -INFINITY; attn_chunk<128>(st, s, ro + vcol, qkv, F.lane); }
            } else {
#pragma unroll
                for (int br = 0; br < 3; ++br) { const int dil = br == 0 ? 1 : br == 1 ? 4 : 16;
                    for (int c = 0; c < 3; ++c) { const int j = -64 + 64 * c + F.lane; const int pos = t + dil * j; const bool valid = (j <= 64) && (pos >= 0) && (pos < S);
                        const int pc = pos < 0 ? 0 : (pos > S - 1 ? S - 1 : pos); const int ro = (sb + pc) * W;
                        float s = qk_dot(qs, qkv + ro + kcol) - slope2 * (float)dil * fabsf((float)j); s = valid ? s : -INFINITY; attn_chunk<128>(st, s, ro + vcol, qkv, F.lane); } }
            }
            const float rl = 1.0f / st.l;
            *(unsigned*)(F.hbuf2 + (size_t)T * DM + h * 128 + 2 * F.lane) = cvt_pk_bf16(st.o[0] * rl, st.o[1] * rl);
        } else {
            const int kvh = h >> 1; const float slope2 = exp2f(-(float)(h + 1)) * LOG2E;
            const float* lp = argp(F, 16);
            const float d1 = wave_sum(lp[F.lane] * lp[128 + F.lane] + lp[64 + F.lane] * lp[192 + F.lane]);
            const float d2 = wave_sum(lp[256 + F.lane] * lp[384 + F.lane] + lp[320 + F.lane] * lp[448 + F.lane]);
            const float lam = expf(d1) - expf(d2) + LAM_INIT2;
            float om[2][4];
#pragma unroll
            for (int mp = 0; mp < 2; ++mp) {
                const int kcol = 2048 + kvh * 256 + mp * 128, vcol = 3072 + kvh * 256;
                q_to_lds(qs, qkv + (size_t)T * W + h * 256 + mp * 128, F.lane);
                asm volatile("s_waitcnt lgkmcnt(0)" ::: "memory");
                OSt<256> st; st.m = -1e30f; st.l = 0.f; st.o[0] = st.o[1] = st.o[2] = st.o[3] = 0.f;
                for (int c = 0; c < S / 64; ++c) { const int pos = 64 * c + F.lane; const int ro = (sb + pos) * W;
                    const float s = qk_dot(qs, qkv + ro + kcol) - slope2 * fabsf((float)(pos - t)); attn_chunk<256>(st, s, ro + vcol, qkv, F.lane); }
                const float rl = 1.0f / st.l;
#pragma unroll
                for (int k = 0; k < 4; ++k) om[mp][k] = st.o[k] * rl;
                asm volatile("s_waitcnt lgkmcnt(0)" ::: "memory");
            }
            float dd[4], ss = 0.f;
#pragma unroll
            for (int k = 0; k < 4; ++k) { dd[k] = om[0][k] - lam * om[1][k]; ss += dd[k] * dd[k]; }
            const float rstd = 1.0f / sqrtf(wave_sum(ss) * (1.f / 256.f) + EPS);
            const f32x4 sg = *(const f32x4*)(argp(F, 17) + 4 * F.lane);
            u32x2 w; w.x = cvt_pk_bf16(dd[0] * rstd * sg[0] * (1.f - LAM_INIT2), dd[1] * rstd * sg[1] * (1.f - LAM_INIT2));
            w.y = cvt_pk_bf16(dd[2] * rstd * sg[2] * (1.f - LAM_INIT2), dd[3] * rstd * sg[3] * (1.f - LAM_INIT2));
            *(u32x2*)(F.hbuf2 + (size_t)T * DM + h * 256 + 4 * F.lane) = w;
        }
    }
}

namespace fa {
using f32x16 = __attribute__((ext_vector_type(16))) float;
using s16x4  = __attribute__((ext_vector_type(4))) short;
constexpr int KVBLK = 64;
constexpr int SHM_V = KVBLK * 128 * 2, SHM_K = SHM_V;
constexpr float THR2 = 8.f * LOG2E;
#define KSWZ(row, colB) ((row) * 256 + ((colB) ^ (((row) & 7) << 4)))
#define SBAR() __builtin_amdgcn_sched_barrier(0)
__device__ __forceinline__ int crow(int r, int hi) { return (r & 3) + 8 * (r >> 2) + 4 * hi; }
__device__ __forceinline__ int v_st(int k, int c) { const int kk = (k & ~0xC) | ((k & 4) << 1) | ((k & 8) >> 1); return ((kk >> 3) * 4 + (c >> 5)) * 512 + ((kk & 7) * 32 + (c & 31)) * 2; }
__device__ __forceinline__ int v_rd_base(int lane) { return ((lane & 3) << 3) | (((lane >> 2) & 3) << 6) | (((lane >> 4) & 1) << 5) | (((lane >> 5) & 1) << 8); }
constexpr int v_rd_off(int d0, int ks, int half) { return d0 * 512 + ks * 4096 + half * 2048; }
template <int OFF> __device__ __forceinline__ s16x4 tr_read(int vb) { s16x4 r; asm volatile("ds_read_b64_tr_b16 %0, %1 offset:%2" : "=&v"(r) : "v"(vb), "i"(OFF) : "memory"); return r; }
template <int D0> __device__ __forceinline__ void pv_one(f32x16& od, int vb, bf16x8 pa0, bf16x8 pa1, bf16x8 pa2, bf16x8 pa3) {
  s16x4 l0 = tr_read<v_rd_off(D0, 0, 0)>(vb), h0 = tr_read<v_rd_off(D0, 0, 1)>(vb), l1 = tr_read<v_rd_off(D0, 1, 0)>(vb), h1 = tr_read<v_rd_off(D0, 1, 1)>(vb);
  s16x4 l2 = tr_read<v_rd_off(D0, 2, 0)>(vb), h2 = tr_read<v_rd_off(D0, 2, 1)>(vb), l3 = tr_read<v_rd_off(D0, 3, 0)>(vb), h3 = tr_read<v_rd_off(D0, 3, 1)>(vb);
  asm volatile("s_waitcnt lgkmcnt(0)" : "+v"(l0), "+v"(h0), "+v"(l1), "+v"(h1), "+v"(l2), "+v"(h2), "+v"(l3), "+v"(h3) :: "memory");
#define PK(L, H) (bf16x8){L[0], L[1], L[2], L[3], H[0], H[1], H[2], H[3]}
  od = __builtin_amdgcn_mfma_f32_32x32x16_bf16(pa0, PK(l0, h0), od, 0, 0, 0);
  od = __builtin_amdgcn_mfma_f32_32x32x16_bf16(pa1, PK(l1, h1), od, 0, 0, 0);
  od = __builtin_amdgcn_mfma_f32_32x32x16_bf16(pa2, PK(l2, h2), od, 0, 0, 0);
  od = __builtin_amdgcn_mfma_f32_32x32x16_bf16(pa3, PK(l3, h3), od, 0, 0, 0);
#undef PK
}
__device__ __forceinline__ bf16x8 kread128(int a) { bf16x8 r; asm volatile("ds_read_b128 %0, %1" : "=&v"(r) : "v"(a) : "memory"); return r; }
template <bool ZERO, class HOOK> __device__ __forceinline__ void qkt_pipe(f32x16& p0, f32x16& p1, const LAS char* Ks, const bf16x8* qr, int r32, int hi, HOOK&& hook) {
  if (ZERO) { p0 = f32x16{}; p1 = f32x16{}; }
#define KRD(d0_, R) kread128((int)(size_t)(Ks + KSWZ((R) + r32, ((d0_) * 16 + hi * 8) * 2)))
  bf16x8 a0 = KRD(0, 0), a1 = KRD(0, 32);
#pragma unroll
  for (int d0 = 0; d0 < 8; ++d0) { bf16x8 c0 = a0, c1 = a1;
    if (d0 + 1 < 8) { c0 = KRD(d0 + 1, 0); c1 = KRD(d0 + 1, 32); asm volatile("s_waitcnt lgkmcnt(2)" : "+v"(a0), "+v"(a1) :: "memory"); }
    else asm volatile("s_waitcnt lgkmcnt(0)" : "+v"(a0), "+v"(a1) :: "memory");
    p0 = __builtin_amdgcn_mfma_f32_32x32x16_bf16(a0, qr[d0], p0, 0, 0, 0);
    p1 = __builtin_amdgcn_mfma_f32_32x32x16_bf16(a1, qr[d0], p1, 0, 0, 0);
    hook(d0);
    a0 = c0; a1 = c1; }
#undef KRD
}
#define VRD8(S, D0, vb) s16x4 S##l0 = tr_read<v_rd_off(D0, 0, 0)>(vb), S##h0 = tr_read<v_rd_off(D0, 0, 1)>(vb), S##l1 = tr_read<v_rd_off(D0, 1, 0)>(vb), S##h1 = tr_read<v_rd_off(D0, 1, 1)>(vb), \
                              S##l2 = tr_read<v_rd_off(D0, 2, 0)>(vb), S##h2 = tr_read<v_rd_off(D0, 2, 1)>(vb), S##l3 = tr_read<v_rd_off(D0, 3, 0)>(vb), S##h3 = tr_read<v_rd_off(D0, 3, 1)>(vb)
#define VWT8(S, N) asm volatile("s_waitcnt lgkmcnt(" #N ")" : "+v"(S##l0), "+v"(S##h0), "+v"(S##l1), "+v"(S##h1), "+v"(S##l2), "+v"(S##h2), "+v"(S##l3), "+v"(S##h3) :: "memory")
#define VPK(L, H) (bf16x8){L[0], L[1], L[2], L[3], H[0], H[1], H[2], H[3]}
#define VMM4(S, od) do { od = __builtin_amdgcn_mfma_f32_32x32x16_bf16(pa0, VPK(S##l0, S##h0), od, 0, 0, 0); od = __builtin_amdgcn_mfma_f32_32x32x16_bf16(pa1, VPK(S##l1, S##h1), od, 0, 0, 0); \
                           od = __builtin_amdgcn_mfma_f32_32x32x16_bf16(pa2, VPK(S##l2, S##h2), od, 0, 0, 0); od = __builtin_amdgcn_mfma_f32_32x32x16_bf16(pa3, VPK(S##l3, S##h3), od, 0, 0, 0); } while (0)
__device__ __forceinline__ void pv_pipe8(f32x16* oA, f32x16* oB, int vbA, int vbB, bf16x8 pa0, bf16x8 pa1, bf16x8 pa2, bf16x8 pa3) {
  VRD8(g0, 0, vbA);
  VRD8(g1, 1, vbA); VWT8(g0, 8); VMM4(g0, oA[0]);
  VRD8(g2, 2, vbA); VWT8(g1, 8); VMM4(g1, oA[1]);
  VRD8(g3, 3, vbA); VWT8(g2, 8); VMM4(g2, oA[2]);
  VRD8(g4, 0, vbB); VWT8(g3, 8); VMM4(g3, oA[3]);
  VRD8(g5, 1, vbB); VWT8(g4, 8); VMM4(g4, oB[0]);
  VRD8(g6, 2, vbB); VWT8(g5, 8); VMM4(g5, oB[1]);
  VRD8(g7, 3, vbB); VWT8(g6, 8); VMM4(g6, oB[2]);
  VWT8(g7, 0); VMM4(g7, oB[3]);
}
#define BI2(R) do { constexpr float c_ = (float)(((R) & 3) + 8 * ((R) >> 2)); p0[R] = fmaf(fabsf(dubn + c_), nslope, negm); p1[R] = fmaf(fabsf(dubn + (c_ + 32.f)), nslope, negm); } while (0)
#define VRD4(S, D0, KS, vb) s16x4 S##l0 = tr_read<v_rd_off(D0, KS, 0)>(vb), S##h0 = tr_read<v_rd_off(D0, KS, 1)>(vb), S##l1 = tr_read<v_rd_off(D0, KS + 1, 0)>(vb), S##h1 = tr_read<v_rd_off(D0, KS + 1, 1)>(vb)
#define VWT4(S, N) asm volatile("s_waitcnt lgkmcnt(" #N ")" : "+v"(S##l0), "+v"(S##h0), "+v"(S##l1), "+v"(S##h1) :: "memory")
#define VMM2(S, od, PA, PB) do { od = __builtin_amdgcn_mfma_f32_32x32x16_bf16(PA, VPK(S##l0, S##h0), od, 0, 0, 0); od = __builtin_amdgcn_mfma_f32_32x32x16_bf16(PB, VPK(S##l1, S##h1), od, 0, 0, 0); } while (0)
__device__ __forceinline__ void pv_pipe8b(f32x16* oA, f32x16* oB, int vbA, int vbB, bf16x8 pa0, bf16x8 pa1, bf16x8 pa2, bf16x8 pa3, f32x16& p0, f32x16& p1, float dubn, float nslope, float negm) {
  VRD4(h0, 0, 0, vbA);
  VRD4(h1, 0, 2, vbA); VWT4(h0, 4); VMM2(h0, oA[0], pa0, pa1); BI2(0);
  VRD4(h2, 1, 0, vbA); VWT4(h1, 4); VMM2(h1, oA[0], pa2, pa3); BI2(1);
  VRD4(h3, 1, 2, vbA); VWT4(h2, 4); VMM2(h2, oA[1], pa0, pa1); BI2(2);
  VRD4(h4, 2, 0, vbA); VWT4(h3, 4); VMM2(h3, oA[1], pa2, pa3); BI2(3);
  VRD4(h5, 2, 2, vbA); VWT4(h4, 4); VMM2(h4, oA[2], pa0, pa1); BI2(4);
  VRD4(h6, 3, 0, vbA); VWT4(h5, 4); VMM2(h5, oA[2], pa2, pa3); BI2(5);
  VRD4(h7, 3, 2, vbA); VWT4(h6, 4); VMM2(h6, oA[3], pa0, pa1); BI2(6);
  VRD4(h8, 0, 0, vbB); VWT4(h7, 4); VMM2(h7, oA[3], pa2, pa3); BI2(7);
  VRD4(h9, 0, 2, vbB); VWT4(h8, 4); VMM2(h8, oB[0], pa0, pa1); BI2(8);
  VRD4(h10, 1, 0, vbB); VWT4(h9, 4); VMM2(h9, oB[0], pa2, pa3); BI2(9);
  VRD4(h11, 1, 2, vbB); VWT4(h10, 4); VMM2(h10, oB[1], pa0, pa1); BI2(10);
  VRD4(h12, 2, 0, vbB); VWT4(h11, 4); VMM2(h11, oB[1], pa2, pa3); BI2(11);
  VRD4(h13, 2, 2, vbB); VWT4(h12, 4); VMM2(h12, oB[2], pa0, pa1); BI2(12);
  VRD4(h14, 3, 0, vbB); VWT4(h13, 4); VMM2(h13, oB[2], pa2, pa3); BI2(13);
  VRD4(h15, 3, 2, vbB); VWT4(h14, 4); VMM2(h14, oB[3], pa0, pa1); BI2(14);
  VWT4(h15, 0); VMM2(h15, oB[3], pa2, pa3); BI2(15);
}
__device__ __forceinline__ void pv_d0_fenced(f32x16* o, int vb, bf16x8 pa0, bf16x8 pa1, bf16x8 pa2, bf16x8 pa3) {
  pv_one<0>(o[0], vb, pa0, pa1, pa2, pa3); SBAR(); pv_one<1>(o[1], vb, pa0, pa1, pa2, pa3); SBAR(); pv_one<2>(o[2], vb, pa0, pa1, pa2, pa3); SBAR(); pv_one<3>(o[3], vb, pa0, pa1, pa2, pa3); SBAR();
}
__device__ __forceinline__ void pv_d0(f32x16* o, int vb, bf16x8 pa0, bf16x8 pa1, bf16x8 pa2, bf16x8 pa3) {
  pv_one<0>(o[0], vb, pa0, pa1, pa2, pa3); pv_one<1>(o[1], vb, pa0, pa1, pa2, pa3); pv_one<2>(o[2], vb, pa0, pa1, pa2, pa3); pv_one<3>(o[3], vb, pa0, pa1, pa2, pa3);
}
__device__ __forceinline__ void qkt(f32x16& p0, f32x16& p1, const LAS char* Ks, const bf16x8* qr, int r32, int hi) {
  p0 = f32x16{}; p1 = f32x16{};
#pragma unroll
  for (int d0 = 0; d0 < 8; ++d0) { const int cb = (d0 * 16 + hi * 8) * 2;
    const bf16x8 b0 = *(const LAS bf16x8*)(Ks + KSWZ(r32, cb));
    const bf16x8 b1 = *(const LAS bf16x8*)(Ks + KSWZ(32 + r32, cb));
    p0 = __builtin_amdgcn_mfma_f32_32x32x16_bf16(b0, qr[d0], p0, 0, 0, 0);
    p1 = __builtin_amdgcn_mfma_f32_32x32x16_bf16(b1, qr[d0], p1, 0, 0, 0); }
}
template <int WIN, bool ALIBI>
__device__ __forceinline__ void partialSM(f32x16& p0, f32x16& p1, float& m_reg, float& mn, float& alpha, float dub, float nslope, float lo, float hi_, bool tile_ok) {
  if (ALIBI || WIN) {
#pragma unroll
    for (int r = 0; r < 16; ++r) { const float c = (float)((r & 3) + 8 * (r >> 2)); const float du0 = dub + c, du1 = dub + (c + 32.f);
      float t0 = p0[r], t1 = p1[r];
      if (ALIBI) { t0 = fmaf(fabsf(du0), nslope, t0); t1 = fmaf(fabsf(du1), nslope, t1); }
      if (WIN) { t0 = (du0 >= lo && du0 <= hi_) ? t0 : -INFINITY; t1 = (du1 >= lo && du1 <= hi_) ? t1 : -INFINITY; }
      p0[r] = t0; p1[r] = t1; }
    if (WIN) { if (!tile_ok) {
#pragma unroll
      for (int r = 0; r < 16; ++r) { p0[r] = -INFINITY; p1[r] = -INFINITY; } } }
  }
  float pmax = p0[0];
#pragma unroll
  for (int r = 1; r < 16; ++r) pmax = fmaxf(pmax, p0[r]);
#pragma unroll
  for (int r = 0; r < 16; ++r) pmax = fmaxf(pmax, p1[r]);
  { auto rr = __builtin_amdgcn_permlane32_swap(__float_as_uint(pmax), __float_as_uint(pmax), false, false);
    pmax = fmaxf(__uint_as_float(rr[0]), __uint_as_float(rr[1])); }
  if (__builtin_expect(__all(pmax - m_reg <= THR2), 1)) { mn = m_reg; alpha = 1.f; }
  else { mn = fmaxf(m_reg, pmax); alpha = __builtin_amdgcn_exp2f(m_reg - mn); m_reg = mn; }
#pragma unroll
  for (int r = 0; r < 16; ++r) { p0[r] = p0[r] - mn; p1[r] = p1[r] - mn; }
#pragma unroll
  for (int r = 0; r < 16; ++r) p0[r] = __builtin_amdgcn_exp2f(p0[r]);
}
template <bool ALIBI>
__device__ __forceinline__ void pv_psm(f32x16* o, int vb, bf16x8 pa0, bf16x8 pa1, bf16x8 pa2, bf16x8 pa3, f32x16& p0, f32x16& p1, float& m_reg, float& mn, float& alpha, float dub, float nslope) {
  pv_one<0>(o[0], vb, pa0, pa1, pa2, pa3);
  if (ALIBI) {
#pragma unroll
    for (int r = 0; r < 16; ++r) { const float c = (float)((r & 3) + 8 * (r >> 2)); p0[r] = fmaf(fabsf(dub + c), nslope, p0[r]); p1[r] = fmaf(fabsf(dub + (c + 32.f)), nslope, p1[r]); } }
  float pmax = p0[0];
#pragma unroll
  for (int r = 1; r < 16; ++r) pmax = fmaxf(pmax, p0[r]);
  pv_one<1>(o[1], vb, pa0, pa1, pa2, pa3);
#pragma unroll
  for (int r = 0; r < 16; ++r) pmax = fmaxf(pmax, p1[r]);
  { auto rr = __builtin_amdgcn_permlane32_swap(__float_as_uint(pmax), __float_as_uint(pmax), false, false);
    pmax = fmaxf(__uint_as_float(rr[0]), __uint_as_float(rr[1])); }
  { const bool keep = __all(pmax - m_reg <= THR2); const float mnew = fmaxf(m_reg, pmax); mn = keep ? m_reg : mnew; alpha = __builtin_amdgcn_exp2f(m_reg - mn); m_reg = mn; }
#pragma unroll
  for (int r = 0; r < 16; ++r) p0[r] = p0[r] - mn;
  pv_one<2>(o[2], vb, pa0, pa1, pa2, pa3);
#pragma unroll
  for (int r = 0; r < 16; ++r) p1[r] = p1[r] - mn;
#pragma unroll
  for (int r = 0; r < 8; ++r) p0[r] = __builtin_amdgcn_exp2f(p0[r]);
  pv_one<3>(o[3], vb, pa0, pa1, pa2, pa3);
#pragma unroll
  for (int r = 8; r < 16; ++r) p0[r] = __builtin_amdgcn_exp2f(p0[r]);
}
__device__ __forceinline__ void finishSM(f32x16& p0, f32x16& p1, float alpha, float& l_reg, bf16x8& pa0, bf16x8& pa1, bf16x8& pa2, bf16x8& pa3) {
#pragma unroll
  for (int r = 0; r < 16; ++r) p1[r] = __builtin_amdgcn_exp2f(p1[r]);
  float ps = 0;
#pragma unroll
  for (int r = 0; r < 16; ++r) ps += p0[r];
#pragma unroll
  for (int r = 0; r < 16; ++r) ps += p1[r];
  { auto rr = __builtin_amdgcn_permlane32_swap(__float_as_uint(ps), __float_as_uint(ps), false, false);
    ps = __uint_as_float(rr[0]) + __uint_as_float(rr[1]); }
  l_reg = l_reg * alpha + ps;
#define PK4(P, BASE, OUT) do { unsigned a0 = cvt_pk_bf16(P[BASE + 0], P[BASE + 1]), a1 = cvt_pk_bf16(P[BASE + 2], P[BASE + 3]);   \
    unsigned b0 = cvt_pk_bf16(P[BASE + 4], P[BASE + 5]), b1 = cvt_pk_bf16(P[BASE + 6], P[BASE + 7]);                              \
    auto r0 = __builtin_amdgcn_permlane32_swap(a0, b0, false, false); auto r1 = __builtin_amdgcn_permlane32_swap(a1, b1, false, false); \
    u32x4 w = {r0[0], r1[0], r0[1], r1[1]}; OUT = *reinterpret_cast<bf16x8*>(&w); } while (0)
  PK4(p0, 0, pa0); PK4(p0, 8, pa1); PK4(p1, 0, pa2); PK4(p1, 8, pa3);
#undef PK4
}
struct Item {
  const bf16_t* qkv; int W;
  bf16_t* O; int ocol;
  float* lse; int hh;
  int seq_base, SU, dil, c0, u0, ukb0, NT, two;
  int qcol, kcol, vcol;
  float nslope, sink2, nlam;
  const float* kmax2;
  const float* subg;
  const float* ropetab; const float* qgain;
};
template <int WIN, bool ALIBI, int EPI, bool SINK>
__device__ __forceinline__ void attn_item(const Item& I, char* lds, int tid_in) {
  int tid = tid_in; asm volatile("" : "+v"(tid));
  const int wid = __builtin_amdgcn_readfirstlane(tid >> 6), lane = tid & 63, r32 = lane & 31, hi = lane >> 5;
  LAS char* V_lds = (LAS char*)lds; LAS char* K_lds = V_lds + 2 * SHM_V;
  LAS float* wsf = (LAS float*)(V_lds + (WIN ? 4 : 2) * (SHM_V + SHM_K)) + wid * 64; LAS float* li_l = wsf; LAS float* al_l = wsf + 32;
  float m_reg = SINK ? I.sink2 : -1e30f, l_reg = SINK ? 1.f : 0.f; f32x16 o[4] = {}; bf16x8 qr[8];
  const int two = I.two;
  const int wcls = two ? (wid >> 2) : 0;
  const int uq = I.u0 + (two ? ((wid & 3) * 32 + r32) : (wid * 32 + r32));
  { const bf16_t* Qw = I.qkv + (size_t)(I.seq_base + I.c0 + wcls + I.dil * uq) * I.W + I.qcol + hi * 8;
#pragma unroll
    for (int d0 = 0; d0 < 8; ++d0) qr[d0] = LDG(bf16x8, Qw + d0 * 16); }
  if constexpr (WIN == 0 && !ALIBI) { if (I.ropetab) {
#define BF2F(v) __uint_as_float((unsigned)(unsigned short)(v) << 16)
    float ss = 0.f;
#pragma unroll
    for (int d0 = 0; d0 < 8; ++d0)
#pragma unroll
      for (int e = 0; e < 8; ++e) { const float x = BF2F(qr[d0][e]); ss = fmaf(x, x, ss); }
    { auto rr = __builtin_amdgcn_permlane32_swap(__float_as_uint(ss), __float_as_uint(ss), false, false); ss = __uint_as_float(rr[0]) + __uint_as_float(rr[1]); }
    const float rs = QSCALE / sqrtf(ss * (1.f / 128.f) + EPS);
#pragma unroll
    for (int ax = 0; ax < 2; ++ax) { const int pos = ax ? (uq & 63) : (uq >> 6);
#pragma unroll
      for (int pi = 0; pi < 2; ++pi) { const int dl = 4 * ax + pi, dh = dl + 2;
        const float* tp = I.ropetab + (size_t)(pos * 32 + pi * 16 + hi * 8) * 2; const float* gl = I.qgain + dl * 16 + hi * 8; const float* gh = I.qgain + dh * 16 + hi * 8;
        const f32x4 t0 = LDG(f32x4, tp), t1 = LDG(f32x4, tp + 4), t2 = LDG(f32x4, tp + 8), t3 = LDG(f32x4, tp + 12);
        const f32x4 ga = LDG(f32x4, gl), gb = LDG(f32x4, gl + 4), gc = LDG(f32x4, gh), gd = LDG(f32x4, gh + 4);
        const float cs[8] = {t0[0], t0[2], t1[0], t1[2], t2[0], t2[2], t3[0], t3[2]}, sn[8] = {t0[1], t0[3], t1[1], t1[3], t2[1], t2[3], t3[1], t3[3]};
        const float gL[8] = {ga[0], ga[1], ga[2], ga[3], gb[0], gb[1], gb[2], gb[3]}, gH[8] = {gc[0], gc[1], gc[2], gc[3], gd[0], gd[1], gd[2], gd[3]};
        unsigned wl[4], wh[4];
#pragma unroll
        for (int e2 = 0; e2 < 4; ++e2) { float ol[2], oh[2];
#pragma unroll
          for (int q = 0; q < 2; ++q) { const int e = 2 * e2 + q; const float yl = BF2F(qr[dl][e]) * rs * gL[e], yh = BF2F(qr[dh][e]) * rs * gH[e];
            ol[q] = yl * cs[e] - yh * sn[e]; oh[q] = yh * cs[e] + yl * sn[e]; }
          wl[e2] = cvt_pk_bf16(ol[0], ol[1]); wh[e2] = cvt_pk_bf16(oh[0], oh[1]); }
        { u32x4 w = {wl[0], wl[1], wl[2], wl[3]}; qr[dl] = *reinterpret_cast<bf16x8*>(&w); }
        { u32x4 w = {wh[0], wh[1], wh[2], wh[3]}; qr[dh] = *reinterpret_cast<bf16x8*>(&w); } } }
#undef BF2F
  } }
  const int uqw = I.u0 + (two ? (wid & 3) * 32 : wid * 32);
  float lse_old = 0.f;
  if (EPI == 2) { if (hi == 0) lse_old = LDG(float, I.lse + (size_t)(I.seq_base + I.c0 + wcls + I.dil * uq) * 16 + I.hh); }
  const float lo = WIN ? (float)max(-WIN, -uq) : 0.f, hi_ = WIN ? (float)min(WIN, I.SU - 1 - uq) : 0.f;
  const float dq = (float)(4 * hi - uq);
  const int sr = tid >> 4, sc = (tid & 15) * 8, vst0 = v_st(sr, sc), vst1 = v_st(32 + sr, sc);
  const int vb0 = (int)(unsigned)(uintptr_t)V_lds + v_rd_base(lane);
  struct { bf16x8 vs0, vs1, ks0, ks1; } sr_[2];
#define TILE_UKB(n) (two ? 64 * ((n) & 1) : I.ukb0 + 64 * (n))
#define TILE_OK(n) (!two || ((n) >> 1) == (wid >> 2))
#define ACT(n) (!WIN || (TILE_OK(n) && TILE_UKB(n) + 63 >= uqw - WIN && TILE_UKB(n) <= uqw + 31 + WIN))
#define SLOAD(i, n) do { const int ukb_ = TILE_UKB(n); const int cls_ = I.c0 + (two ? ((n) >> 1) : 0); int u0_ = ukb_ + sr, u1_ = ukb_ + 32 + sr; \
    if (WIN) { u0_ = min(max(u0_, 0), I.SU - 1); u1_ = min(max(u1_, 0), I.SU - 1); } \
    const bf16_t* r0_ = I.qkv + (size_t)(I.seq_base + cls_ + I.dil * u0_) * I.W + sc; const bf16_t* r1_ = I.qkv + (size_t)(I.seq_base + cls_ + I.dil * u1_) * I.W + sc; \
    sr_[i].vs0 = LDG(bf16x8, r0_ + I.vcol); sr_[i].vs1 = LDG(bf16x8, r1_ + I.vcol); \
    sr_[i].ks0 = LDG(bf16x8, r0_ + I.kcol); sr_[i].ks1 = LDG(bf16x8, r1_ + I.kcol); } while (0)
#define SWRITE(b, i) do { *(LAS bf16x8*)(V_lds + (b) * SHM_V + vst0) = sr_[i].vs0; *(LAS bf16x8*)(V_lds + (b) * SHM_V + vst1) = sr_[i].vs1; const int kc = sc * 2; \
    *(LAS bf16x8*)(K_lds + (b) * SHM_K + KSWZ(sr, kc)) = sr_[i].ks0; *(LAS bf16x8*)(K_lds + (b) * SHM_K + KSWZ(32 + sr, kc)) = sr_[i].ks1; } while (0)
#define SWAIT() asm volatile("s_waitcnt vmcnt(4)" ::: "memory")
#define RESC(a) do { if (__any((a) < 1.f)) { if (hi == 0) al_l[r32] = (a); asm volatile("s_waitcnt lgkmcnt(0)" ::: "memory"); \
    _Pragma("unroll") for (int d = 0; d < 4; ++d) _Pragma("unroll") for (int r = 0; r < 16; ++r) o[d][r] *= al_l[crow(r, hi)]; } } while (0)
#define PSM(P0, P1, MN, AL, n) partialSM<WIN, ALIBI>(P0, P1, m_reg, MN, AL, dq + (float)TILE_UKB(n), I.nslope, lo, hi_, TILE_OK(n))
  f32x16 pA0, pA1, pB0, pB1; float mnA, mnB, alA, alB; bf16x8 pa0, pa1, pa2, pa3; const int NT = I.NT;
  constexpr int SE = 0, SO = 1;
  if constexpr (WIN == 0) {
  SLOAD(SE, 0); asm volatile("s_waitcnt vmcnt(0)" ::: "memory"); SWRITE(0, SE); __syncthreads();
  qkt(pA0, pA1, K_lds, qr, r32, hi); PSM(pA0, pA1, mnA, alA, 0);
  SLOAD(SO, 1); if (2 < NT) SLOAD(SE, 2);
  SWAIT(); SWRITE(1, SO); __syncthreads();
  for (int j = 1; j + 1 < NT; j += 2) {
    SBAR(); qkt(pB0, pB1, K_lds + SHM_K, qr, r32, hi);
    finishSM(pA0, pA1, alA, l_reg, pa0, pa1, pa2, pa3); SBAR();
    SLOAD(SO, j + 2); SBAR();
    pv_psm<ALIBI>(o, vb0, pa0, pa1, pa2, pa3, pB0, pB1, m_reg, mnB, alB, dq + (float)TILE_UKB(j), I.nslope);
    __syncthreads(); SWAIT(); SWRITE(0, SE);
    RESC(alB); __syncthreads();
    SBAR(); qkt(pA0, pA1, K_lds, qr, r32, hi);
    finishSM(pB0, pB1, alB, l_reg, pa0, pa1, pa2, pa3); SBAR();
    if (j + 3 < NT) SLOAD(SE, j + 3); SBAR();
    pv_psm<ALIBI>(o, vb0 + SHM_V, pa0, pa1, pa2, pa3, pA0, pA1, m_reg, mnA, alA, dq + (float)TILE_UKB(j + 1), I.nslope);
    __syncthreads(); SWAIT(); SWRITE(1, SO);
    RESC(alA); __syncthreads();
  }
  SBAR(); qkt(pB0, pB1, K_lds + SHM_K, qr, r32, hi);
  finishSM(pA0, pA1, alA, l_reg, pa0, pa1, pa2, pa3); SBAR();
  pv_psm<ALIBI>(o, vb0, pa0, pa1, pa2, pa3, pB0, pB1, m_reg, mnB, alB, dq + (float)TILE_UKB(NT - 1), I.nslope);
  __syncthreads(); RESC(alB);
  finishSM(pB0, pB1, alB, l_reg, pa0, pa1, pa2, pa3); SBAR();
  pv_d0(o, vb0 + SHM_V, pa0, pa1, pa2, pa3);
  } else {
  const int hh = wid >> 2, tl = tid & 255, sr4 = tl >> 4, sc4 = (tl & 15) * 8;
  LAS char* Vh = V_lds + hh * (2 * (SHM_V + SHM_K)); LAS char* Kh = Vh + 2 * SHM_V;
  const int vbh = (int)(unsigned)(uintptr_t)Vh + v_rd_base(lane);
  const int clsw = I.c0 + wcls, NTw = two ? 2 : (128 + 2 * WIN) / 64, ukbw = two ? 0 : I.u0 + 128 * hh - WIN;
  bf16x8 stv[4], stk[4];
#define WUKB(n) (ukbw + 64 * (n))
#define WACT(n) (WUKB(n) + 63 >= uqw - WIN && WUKB(n) <= uqw + 31 + WIN)
#define WSLOAD(n) do { _Pragma("unroll") for (int i_ = 0; i_ < 4; ++i_) { int u_ = WUKB(n) + sr4 + 16 * i_; u_ = min(max(u_, 0), I.SU - 1); \
      const bf16_t* rp_ = I.qkv + (size_t)(I.seq_base + clsw + I.dil * u_) * I.W + sc4; stv[i_] = LDG(bf16x8, rp_ + I.vcol); stk[i_] = LDG(bf16x8, rp_ + I.kcol); } } while (0)
#define WSWRITE(b) do { _Pragma("unroll") for (int i_ = 0; i_ < 4; ++i_) { *(LAS bf16x8*)(Vh + (b) * SHM_V + v_st(sr4 + 16 * i_, sc4)) = stv[i_]; \
      *(LAS bf16x8*)(Kh + (b) * SHM_K + KSWZ(sr4 + 16 * i_, sc4 * 2)) = stk[i_]; } } while (0)
  WSLOAD(0); asm volatile("s_waitcnt vmcnt(0)" ::: "memory"); WSWRITE(0); if (1 < NTw) WSLOAD(1); __syncthreads();
  for (int n = 0; n < NTw; ++n) { const int bsel = n & 1;
    if (WACT(n)) { qkt(pA0, pA1, Kh + bsel * SHM_K, qr, r32, hi);
      partialSM<WIN, ALIBI>(pA0, pA1, m_reg, mnA, alA, dq + (float)WUKB(n), I.nslope, lo, hi_, true); RESC(alA);
      finishSM(pA0, pA1, alA, l_reg, pa0, pa1, pa2, pa3); SBAR(); pv_d0(o, vbh + bsel * SHM_V, pa0, pa1, pa2, pa3); }
    if (n + 1 < NTw) { asm volatile("s_waitcnt vmcnt(0)" ::: "memory"); WSWRITE(bsel ^ 1); if (n + 2 < NTw) WSLOAD(n + 2); }
    __syncthreads();
  }
#undef WUKB
#undef WACT
#undef WSLOAD
#undef WSWRITE
  }
  const int tokq = I.seq_base + I.c0 + wcls + I.dil * uq;
  if (EPI == 0 || EPI == 1 || EPI == 3 || EPI == 4 || EPI == 5) { if (hi == 0) { li_l[r32] = ((EPI == 3 || EPI == 5) ? I.nlam : 1.f) / l_reg; if (EPI == 1) STG(float, I.lse + (size_t)tokq * 16 + I.hh) = m_reg + __log2f(l_reg); } }
  if (EPI == 2) { if (hi == 0) { float* lp = I.lse + (size_t)tokq * 16 + I.hh; const float lold = lse_old, lcur = m_reg + __log2f(l_reg), mx = fmaxf(lold, lcur);
      const float wa = __builtin_amdgcn_exp2f(lold - mx), wb = __builtin_amdgcn_exp2f(lcur - mx), den = wa + wb; STG(float, lp) = mx + __log2f(den);
      al_l[r32] = wa / den; li_l[r32] = wb / (den * l_reg); } }
  asm volatile("s_waitcnt lgkmcnt(0)" ::: "memory");
  const int tokw = I.seq_base + I.c0 + wcls + I.dil * (I.u0 + (two ? (wid & 3) * 32 : wid * 32));
  bf16_t* Ow = I.O + (size_t)tokw * DM + I.ocol + r32;
  LAS unsigned* park = (LAS unsigned*)(V_lds + 2 * SHM_V + 2 * SHM_K + 2048) + tid * 32;
  if constexpr (EPI == 4) {
#pragma unroll
    for (int r = 0; r < 16; r += 2) { const float f0 = li_l[crow(r, hi)], f1 = li_l[crow(r + 1, hi)];
#pragma unroll
      for (int d0 = 0; d0 < 4; ++d0) park[(r >> 1) * 4 + d0] = cvt_pk_bf16(o[d0][r] * f0, o[d0][r + 1] * f1); }
  } else if constexpr (EPI == 3) {
    unsigned oldv[16][4];
#pragma unroll
    for (int r = 0; r < 16; ++r) { const bf16_t* Or = Ow + (size_t)(I.dil * crow(r, hi)) * DM;
#pragma unroll
      for (int d0 = 0; d0 < 4; ++d0) oldv[r][d0] = (unsigned)LDG(bf16_t, Or + d0 * 32); }
    asm volatile("" ::: "memory");
#pragma unroll
    for (int r = 0; r < 16; ++r) { const int orow = crow(r, hi); const float f = li_l[orow];
      bf16_t* Or = Ow + (size_t)(I.dil * orow) * DM;
#pragma unroll
      for (int d0 = 0; d0 < 4; ++d0) { const float v = __uint_as_float(oldv[r][d0] << 16) + o[d0][r] * f;
        STG(bf16_t, Or + d0 * 32) = (bf16_t)(cvt_pk_bf16(v, v) & 0xffffu); } }
  } else {
    const int rsub = lane >> 4, ch = lane & 15;
    bf16_t* Orow = I.O + (size_t)tokw * DM + I.ocol + ch * 8;
    u32x4 oldv[(EPI == 2) ? 8 : 1];
    if constexpr (EPI == 2) {
#pragma unroll
      for (int j = 0; j < 8; ++j) oldv[j] = LDG(u32x4, Orow + (size_t)(I.dil * (4 * j + rsub)) * DM); }
    __syncthreads();
    constexpr int RB = (EPI == 2) ? 512 : 256;
    LAS char* Sw = V_lds + wid * (32 * RB);
    if constexpr (EPI == 5) {
#pragma unroll
      for (int r = 0; r < 16; r += 2) { const int or0 = crow(r, hi), or1 = crow(r + 1, hi); const float f0 = li_l[or0], f1 = li_l[or1];
#pragma unroll
        for (int d0 = 0; d0 < 4; ++d0) { const unsigned pk = park[(r >> 1) * 4 + d0]; const float v0 = bf_lo(pk) + o[d0][r] * f0, v1 = bf_hi(pk) + o[d0][r + 1] * f1;
          const unsigned w = cvt_pk_bf16(v0, v1);
          *(LAS bf16_t*)(Sw + or0 * RB + (d0 * 32 + r32) * 2) = (bf16_t)(w & 0xffffu); *(LAS bf16_t*)(Sw + or1 * RB + (d0 * 32 + r32) * 2) = (bf16_t)(w >> 16); } }
    } else {
#pragma unroll
      for (int r = 0; r < 16; ++r) { const int orow = crow(r, hi); const float f = li_l[orow];
#pragma unroll
        for (int d0 = 0; d0 < 4; ++d0) { const float v = o[d0][r] * f;
          if constexpr (EPI == 2) *(LAS float*)(Sw + orow * RB + (d0 * 32 + r32) * 4) = v;
          else *(LAS bf16_t*)(Sw + orow * RB + (d0 * 32 + r32) * 2) = (bf16_t)(cvt_pk_bf16(v, v) & 0xffffu); } }
    }
    asm volatile("s_waitcnt lgkmcnt(0)" ::: "memory");
    if constexpr (EPI == 2) {
#pragma unroll
      for (int j = 0; j < 8; ++j) { const int row = 4 * j + rsub; const float fo = al_l[row];
        const f32x4 a0 = *(const LAS f32x4*)(Sw + row * RB + ch * 32), a1 = *(const LAS f32x4*)(Sw + row * RB + ch * 32 + 16); const u32x4 ov = oldv[j];
        u32x4 w; w.x = cvt_pk_bf16(fo * bf_lo(ov.x) + a0[0], fo * bf_hi(ov.x) + a0[1]); w.y = cvt_pk_bf16(fo * bf_lo(ov.y) + a0[2], fo * bf_hi(ov.y) + a0[3]);
        w.z = cvt_pk_bf16(fo * bf_lo(ov.z) + a1[0], fo * bf_hi(ov.z) + a1[1]); w.w = cvt_pk_bf16(fo * bf_lo(ov.w) + a1[2], fo * bf_hi(ov.w) + a1[3]);
        STG(u32x4, Orow + (size_t)(I.dil * row) * DM) = w; }
    } else {
#pragma unroll
      for (int j = 0; j < 8; ++j) { const int row = 4 * j + rsub; const u32x4 w = *(const LAS u32x4*)(Sw + row * RB + ch * 16);
        STG(u32x4, Orow + (size_t)(I.dil * row) * DM) = w; }
    }
  }
  __syncthreads();
#undef TILE_UKB
#undef TILE_OK
#undef ACT
#undef SLOAD
#undef SWRITE
#undef SWAIT
#undef RESC
#undef PSM
}
template <int EPI>
__device__ __forceinline__ void attn_item_c(const Item& I, char* lds, int tid_in) {
  int tid = tid_in; asm volatile("" : "+v"(tid));
  const int wid = __builtin_amdgcn_readfirstlane(tid >> 6), lane = tid & 63, r32 = lane & 31, hi = lane >> 5;
  constexpr int STG = 3 * SHM_V;
  LAS char* base = (LAS char*)lds;
  LAS float* wsf = (LAS float*)(base + 131072) + wid * 64; LAS float* li_l = wsf; LAS float* al_l = wsf + 32;
  float m_reg = -1e30f, l_reg = 0.f; f32x16 oA[4] = {}, oB[4] = {}; bf16x8 qr[8];
  const int uq = I.u0 + wid * 32 + r32;
  { const bf16_t* Qw = I.qkv + (size_t)(I.seq_base + uq) * I.W + I.qcol + hi * 8;
#pragma unroll
    for (int d0 = 0; d0 < 8; ++d0) qr[d0] = LDG(bf16x8, Qw + d0 * 16); }
  const float dq = (float)(4 * hi - uq);
  const int vb0 = (int)(unsigned)(uintptr_t)base + v_rd_base(lane);
  unsigned gk[2], gv[2];
#pragma unroll
  for (int i = 0; i < 2; ++i) { const int p = i * 8192 + wid * 1024 + lane * 16;
    { const int row = p >> 8, chunk = ((p & 255) >> 4) ^ (row & 7); gk[i] = (unsigned)(row * I.W + chunk * 8) * 2u; }
    { const int sub = p >> 9, within = p & 511, kk = (sub >> 2) * 8 + (within >> 6), k = (kk & ~0xC) | ((kk & 4) << 1) | ((kk & 8) >> 1), c = (sub & 3) * 32 + ((within & 63) >> 1);
      gv[i] = (unsigned)(k * I.W + c) * 2u; } }
  const char* kvb = (const char*)(I.qkv + (size_t)I.seq_base * I.W);
#define CDMA(n, b) do { const char* tb_ = kvb + (size_t)(64 * (n)) * I.W * 2; const char* vbp_ = tb_ + I.vcol * 2; const char* kbp_ = tb_ + I.kcol * 2; LAS char* s_ = base + (b) * STG + wid * 1024; \
    _Pragma("unroll") for (int i_ = 0; i_ < 2; ++i_) { \
      __builtin_amdgcn_global_load_lds((const unsigned*)(vbp_ + gv[i_]), (LAS unsigned*)(s_ + i_ * 8192), 16, 0, 0); \
      __builtin_amdgcn_global_load_lds((const unsigned*)(vbp_ + 256 + gv[i_]), (LAS unsigned*)(s_ + SHM_V + i_ * 8192), 16, 0, 0); \
      __builtin_amdgcn_global_load_lds((const unsigned*)(kbp_ + gk[i_]), (LAS unsigned*)(s_ + 2 * SHM_V + i_ * 8192), 16, 0, 0); } } while (0)
  f32x16 p0, p1; float mn, al; bf16x8 pa0, pa1, pa2, pa3; const int NT = I.NT;
  const int n0 = I.u0 >> 6, ntm = NT - 1;
#define CT(n) (((n) + n0) & ntm)
  CDMA(CT(0), 0);
  m_reg = 0.f;
  { const float dubn = dq + (float)(64 * CT(0)), nslope = I.nslope, negm = 0.f;
    BI2(0); BI2(1); BI2(2); BI2(3); BI2(4); BI2(5); BI2(6); BI2(7); BI2(8); BI2(9); BI2(10); BI2(11); BI2(12); BI2(13); BI2(14); BI2(15); }
  LAS float* xw = (LAS float*)(base + 133184);
  { float qs = 0.f;
#pragma unroll
    for (int d0 = 0; d0 < 8; ++d0)
#pragma unroll
      for (int j = 0; j < 8; ++j) { const float x = __uint_as_float((unsigned)(unsigned short)qr[d0][j] << 16); qs = fmaf(x, x, qs); }
    { auto rr = __builtin_amdgcn_permlane32_swap(__float_as_uint(qs), __float_as_uint(qs), false, false); qs = __uint_as_float(rr[0]) + __uint_as_float(rr[1]); }
    qs = wave_max(qs); if (lane == 0) xw[wid] = qs; }
  asm volatile("s_waitcnt vmcnt(0)" ::: "memory"); __syncthreads();
  float qkb;
  { float q2 = xw[0];
#pragma unroll
    for (int w = 1; w < 8; ++w) q2 = fmaxf(q2, xw[w]);
    qkb = __uint_as_float(__builtin_amdgcn_readfirstlane(__float_as_uint(1.01f * sqrtf(q2 * LDG(float, I.kmax2))))); }
  int R = NT, Lw = 0;
  for (int n = 0, step = 0;; ++step) { const int bsel = step & 1;
    if (step == 4) { float ml = xw[8];
#pragma unroll
      for (int w = 1; w < 8; ++w) ml = fminf(ml, xw[8 + w]);
      const float dmax = fminf((152.f + qkb - ml) / -I.nslope, 1e6f);
      const int cnt = __builtin_amdgcn_readfirstlane(dmax > 0.f ? (int)((dmax + 63.f) * (1.f / 64.f)) : 0);
      R = 3 + min(cnt, NT - n0 - 4); Lw = min(cnt, n0); }
    int nn = n + 1; if (nn > 4 && nn > R && nn < NT - Lw) nn = NT - Lw;
    const bool last = nn >= NT; const int nf = last ? n : nn;
    { const char* tb_ = kvb + (size_t)(64 * CT(nf)) * I.W * 2; const char* vbp_ = tb_ + I.vcol * 2; const char* kbp_ = tb_ + I.kcol * 2; LAS char* s_ = base + (bsel ^ 1) * STG + wid * 1024;
      qkt_pipe<false>(p0, p1, base + bsel * STG + 2 * SHM_V, qr, r32, hi, [&](int st) {
        if (st == 0) __builtin_amdgcn_global_load_lds((const unsigned*)(kbp_ + gk[0]), (LAS unsigned*)(s_ + 2 * SHM_V), 16, 0, 0);
        if (st == 1) __builtin_amdgcn_global_load_lds((const unsigned*)(kbp_ + gk[1]), (LAS unsigned*)(s_ + 2 * SHM_V + 8192), 16, 0, 0);
        if (st == 2) __builtin_amdgcn_global_load_lds((const unsigned*)(vbp_ + gv[0]), (LAS unsigned*)(s_), 16, 0, 0);
        if (st == 3) __builtin_amdgcn_global_load_lds((const unsigned*)(vbp_ + gv[1]), (LAS unsigned*)(s_ + 8192), 16, 0, 0);
        if (st == 4) __builtin_amdgcn_global_load_lds((const unsigned*)(vbp_ + 256 + gv[0]), (LAS unsigned*)(s_ + SHM_V), 16, 0, 0);
        if (st == 5) __builtin_amdgcn_global_load_lds((const unsigned*)(vbp_ + 256 + gv[1]), (LAS unsigned*)(s_ + SHM_V + 8192), 16, 0, 0); }); }
    float pmax = fmaxf(p0[0], p1[0]);
#pragma unroll
    for (int r = 1; r < 16; ++r) pmax = fmaxf(fmaxf(pmax, p0[r]), p1[r]);
    { auto rr = __builtin_amdgcn_permlane32_swap(__float_as_uint(pmax), __float_as_uint(pmax), false, false);
      pmax = fmaxf(__uint_as_float(rr[0]), __uint_as_float(rr[1])); }
    al = 1.f;
    if (step == 0 || !__all(pmax <= THR2)) {
      const float delta = (step == 0) ? pmax : fmaxf(pmax, 0.f); al = (step == 0) ? 1.f : __builtin_amdgcn_exp2f(-delta); m_reg += delta;
#pragma unroll
      for (int r = 0; r < 16; ++r) { p0[r] -= delta; p1[r] -= delta; }
      if (hi == 0) al_l[r32] = al; asm volatile("s_waitcnt lgkmcnt(0)" ::: "memory");
#pragma unroll
      for (int d = 0; d < 4; ++d)
#pragma unroll
        for (int r = 0; r < 16; ++r) { const float a_ = al_l[crow(r, hi)]; oA[d][r] *= a_; oB[d][r] *= a_; } }
    if (step == 3) { const float wm = -wave_max(-m_reg); if (lane == 0) xw[8 + wid] = wm; }
#pragma unroll
    for (int r = 0; r < 16; ++r) p0[r] = __builtin_amdgcn_exp2f(p0[r]);
    finishSM(p0, p1, al, l_reg, pa0, pa1, pa2, pa3); SBAR();
    pv_pipe8b(oA, oB, vb0 + bsel * STG, vb0 + bsel * STG + SHM_V, pa0, pa1, pa2, pa3, p0, p1, dq + (float)(64 * CT(nf)), I.nslope, -m_reg);
    asm volatile("s_waitcnt vmcnt(0)" ::: "memory");
    __syncthreads();
    if (last) break;
    n = nn;
  }
#undef CDMA
#undef CT
#undef BI2
  if (hi == 0) li_l[r32] = ((EPI == 3) ? ((LAS float*)(base + 133120))[wid] : 1.f) / l_reg;
  asm volatile("s_waitcnt lgkmcnt(0)" ::: "memory");
  const int tokw = I.seq_base + I.u0 + wid * 32;
  constexpr int RB = (EPI == 3) ? 512 : 256;
  LAS char* Sw = base + wid * (32 * RB);
  const int rsub = lane >> 4, ch = lane & 15;
  f32x4 dv[2][8][2];
#pragma unroll
  for (int half = 0; half < 2; ++half) {
    f32x16* o = half ? oB : oA;
    asm volatile("s_waitcnt lgkmcnt(0)" ::: "memory");
#pragma unroll
    for (int r = 0; r < 16; ++r) { const int orow = crow(r, hi); const float fq_ = li_l[orow];
#pragma unroll
      for (int d0 = 0; d0 < 4; ++d0) { const float v = o[d0][r] * fq_;
        if constexpr (EPI == 3) *(LAS float*)(Sw + orow * RB + (d0 * 32 + r32) * 4) = v;
        else *(LAS bf16_t*)(Sw + orow * RB + (d0 * 32 + r32) * 2) = (bf16_t)(cvt_pk_bf16(v, v) & 0xffffu); } }
    asm volatile("s_waitcnt lgkmcnt(0)" ::: "memory");
    bf16_t* Orow = I.O + (size_t)tokw * DM + I.ocol + half * 128 + ch * 8;
    if constexpr (EPI == 3) {
      u32x4 oldv[8];
#pragma unroll
      for (int j = 0; j < 8; ++j) oldv[j] = LDG(u32x4, Orow + (size_t)(4 * j + rsub) * DM);
      asm volatile("" ::: "memory");
#pragma unroll
      for (int j = 0; j < 8; ++j) { const int row = 4 * j + rsub;
        const f32x4 a0 = *(const LAS f32x4*)(Sw + row * RB + ch * 32), a1 = *(const LAS f32x4*)(Sw + row * RB + ch * 32 + 16); const u32x4 ov = oldv[j];
        dv[half][j][0] = (f32x4){bf_lo(ov.x) + a0[0], bf_hi(ov.x) + a0[1], bf_lo(ov.y) + a0[2], bf_hi(ov.y) + a0[3]};
        dv[half][j][1] = (f32x4){bf_lo(ov.z) + a1[0], bf_hi(ov.z) + a1[1], bf_lo(ov.w) + a1[2], bf_hi(ov.w) + a1[3]}; }
    } else {
#pragma unroll
      for (int j = 0; j < 8; ++j) { const int row = 4 * j + rsub; const u32x4 w = *(const LAS u32x4*)(Sw + row * RB + ch * 16);
        STG(u32x4, Orow + (size_t)row * DM) = w; }
    }
  }
  if constexpr (EPI == 3) {
    f32x4 gsl[2][2];
#pragma unroll
    for (int half = 0; half < 2; ++half) { gsl[half][0] = LDG(f32x4, I.subg + half * 128 + ch * 8) * (1.f - LAM_INIT2); gsl[half][1] = LDG(f32x4, I.subg + half * 128 + ch * 8 + 4) * (1.f - LAM_INIT2); }
#pragma unroll
    for (int j = 0; j < 8; ++j) { float ss = 0.f;
#pragma unroll
      for (int half = 0; half < 2; ++half)
#pragma unroll
        for (int q = 0; q < 2; ++q) { const f32x4 d = dv[half][j][q]; ss += (d[0] * d[0] + d[1] * d[1]) + (d[2] * d[2] + d[3] * d[3]); }
      ss += swz_xor<1>(ss); ss += swz_xor<2>(ss); ss += swz_xor<4>(ss); ss += swz_xor<8>(ss);
      const float rstd = 1.0f / sqrtf(ss * (1.f / 256.f) + EPS);
#pragma unroll
      for (int half = 0; half < 2; ++half) { const f32x4 y0 = dv[half][j][0] * rstd * gsl[half][0], y1 = dv[half][j][1] * rstd * gsl[half][1];
        u32x4 w; w.x = cvt_pk_bf16(y0[0], y0[1]); w.y = cvt_pk_bf16(y0[2], y0[3]); w.z = cvt_pk_bf16(y1[0], y1[1]); w.w = cvt_pk_bf16(y1[2], y1[3]);
        STG(u32x4, I.O + (size_t)(tokw + 4 * j + rsub) * DM + I.ocol + half * 128 + ch * 8) = w; } }
  }
  asm volatile("s_waitcnt vmcnt(0)" ::: "memory");
  __syncthreads();
}
#undef KSWZ
#undef SBAR
}

struct ItemId { int seq_base, S, h, qb; };
__device__ __forceinline__ ItemId item_decode(int it) { ItemId d;
  if (it < 2048) { d.S = SS_; d.seq_base = TOKP + (it >> 8) * SS_; d.h = (it >> 4) & 15; d.qb = it & 15; }
  else { const int r = it - 2048; d.S = SP_; d.seq_base = (r >> 7) * SP_; d.h = (r >> 3) & 15; d.qb = r & 7; }
  return d; }
template <int MODE> __device__ __forceinline__ void phase_attn_fast(const Frame& F0) {
  const Frame F = fresh(F0);
  float nlam = 0.f;
  if (MODE == 3 || MODE == 2) { const float* lp = argp(F, 16);
    const float d1 = wave_sum(lp[F.lane] * lp[128 + F.lane] + lp[64 + F.lane] * lp[192 + F.lane]);
    const float d2 = wave_sum(lp[256 + F.lane] * lp[384 + F.lane] + lp[320 + F.lane] * lp[448 + F.lane]);
    nlam = -(expf(d1) - expf(d2) + LAM_INIT2); }
  for (int i = 0;; ++i) {
    const int it = i * F.G + F.vcu; if (it >= 2560) break;
    const ItemId d = item_decode(it);
    fa::Item I; I.qkv = F.big; I.O = F.hbuf2; I.lse = F.lse; I.seq_base = d.seq_base; I.two = 0; I.dil = 1; I.c0 = 0; I.SU = d.S; I.u0 = 256 * d.qb; I.hh = d.h;
    I.nslope = 0.f; I.sink2 = 0.f; I.nlam = nlam; I.subg = nullptr; I.ropetab = nullptr; I.qgain = nullptr;
    if (MODE == 2 || MODE == 3) { const int hq = d.h >> 1, vh = d.h & 1, kvh = hq >> 1, mp = (MODE == 3) ? 1 : 0;
      I.W = 4096; I.qcol = hq * 256 + mp * 128; I.kcol = 2048 + kvh * 256 + mp * 128; I.vcol = 3072 + kvh * 256 + vh * 128; I.ocol = hq * 256 + vh * 128;
      I.nslope = -exp2f(-(float)(hq + 1)) * LOG2E; I.ukb0 = 0; I.NT = d.S / 64;
      if (MODE == 2) { fa::attn_item<0, true, 4, false>(I, (char*)F.lds, F.tid);
        I.qcol += 128; I.kcol += 128; fa::attn_item<0, true, 5, false>(I, (char*)F.lds, F.tid); }
      else fa::attn_item<0, true, 3, false>(I, (char*)F.lds, F.tid);
    } else { const int kvh = d.h >> 2; I.W = 3072; I.qcol = d.h * 128; I.kcol = 2048 + kvh * 128; I.vcol = 2560 + kvh * 128; I.ocol = d.h * 128;
      const float slope2 = exp2f(-0.5f * (float)(d.h + 1)) * LOG2E;
      if (MODE == 0) { I.ukb0 = 0; I.NT = d.S / 64; I.ropetab = (const float*)(F.ws + WS_ROPE); I.qgain = argp(F, 9); fa::attn_item<0, false, 0, false>(I, (char*)F.lds, F.tid); }
      if (MODE == 1) { I.ukb0 = I.u0 - 128; I.NT = 8; I.nslope = -slope2; I.sink2 = argp(F, 13)[d.h] * LOG2E; fa::attn_item<128, true, 0, true>(I, (char*)F.lds, F.tid); }
      if (MODE == 4) { I.ukb0 = I.u0 - 64; I.NT = 6; I.nslope = -slope2; fa::attn_item<64, true, 1, false>(I, (char*)F.lds, F.tid); }
      if (MODE == 5 || MODE == 6) { const int dil = (MODE == 5) ? 4 : 16; I.dil = dil; I.SU = d.S / dil; I.nslope = -slope2 * (float)dil;
        const int nqc = I.SU / 256;
        if (nqc == 0) { I.two = 1; I.c0 = 2 * d.qb; I.u0 = 0; I.ukb0 = 0; I.NT = 4; }
        else { I.c0 = d.qb / nqc; I.u0 = 256 * (d.qb % nqc); I.ukb0 = I.u0 - 64; I.NT = 6; }
        fa::attn_item<64, true, 2, false>(I, (char*)F.lds, F.tid); }
    }
  }
}
__device__ __forceinline__ void phase_kmax(const Frame& F0) {
  const Frame F = fresh(F0);
  unsigned* km = (unsigned*)(F.ws + WS_KMAX);
  for (int e = F.gw; e < (TOK / 64) * 8; e += F.NGW) { const int tile = e >> 3, kvh = (e >> 1) & 3, mp = e & 1;
    const bf16_t* kp = F.big + (size_t)(tile * 64 + F.lane) * 4096 + 2048 + kvh * 256 + mp * 128;
    float ss = 0.f;
#pragma unroll
    for (int c = 0; c < 16; ++c) { const bf16x8 v = LDG(bf16x8, kp + c * 8);
#pragma unroll
      for (int j = 0; j < 8; ++j) { const float x = __uint_as_float((unsigned)(unsigned short)v[j] << 16); ss = fmaf(x, x, ss); } }
    const float kmx = wave_max(ss);
    if (F.lane == 0) atomicMax(km + batch_of(tile * 64) * 8 + kvh * 2 + mp, __float_as_uint(kmx)); }
}
__device__ __forceinline__ void phase_attn_c(const Frame& F0) {
  const Frame F = fresh(F0);
  const float* lp = argp(F, 16);
  const float d1 = wave_sum(lp[F.lane] * lp[128 + F.lane] + lp[64 + F.lane] * lp[192 + F.lane]);
  const float d2 = wave_sum(lp[256 + F.lane] * lp[384 + F.lane] + lp[320 + F.lane] * lp[448 + F.lane]);
  { const float nl_ = -(expf(d1) - expf(d2) + LAM_INIT2); if (F.lane == 0) ((LAS float*)(F.lds + 133120))[F.wave] = nl_; }
  const float nlam = 0.f;
  const float* subg = argp(F, 17);
  unsigned* qc = (unsigned*)(F.ws + WS_CQ);
  const int q0 = (int)blockIdx.x & 7;
  LAS int* slot = (LAS int*)(F.lds + 133248);
  if (F.tid == 0) slot[2] = 0;
  for (int i = 0;; ++i) {
    if (F.tid == 0) { int qv = slot[2], w_ = -1;
      while (qv < 8) { const int qq = (q0 + qv) & 7; const int k_ = (int)atomicAdd(qc + qq * 32, 1u); if (k_ < 160) { w_ = qq * 256 + k_; break; } ++qv; }
      slot[2] = qv; slot[i & 1] = w_; }
    __syncthreads();
    const int w = __builtin_amdgcn_readfirstlane(slot[i & 1]); if (w < 0) break;
    const int q_ = w >> 8, seg = (w & 255) >> 5, j = w & 31;
    int seq_base, S, hq, qb;
    if (seg != 3) { const int kvh_ = (seg == 4) ? 0 : 3 - seg, i_ = (kvh_ - q_) & 3, t = j & 15;
      S = SS_; seq_base = TOKP + (2 * i_ + (q_ >> 2)) * SS_; hq = 2 * kvh_ + 1 - (j >> 4); qb = (t & 1) ? 8 + (t >> 1) : 7 - (t >> 1); }
    else { const int t = j & 7; S = SP_; seq_base = (q_ >> 1) * SP_; hq = 4 * (q_ & 1) + 3 - (j >> 3); qb = (t & 1) ? 4 + (t >> 1) : 3 - (t >> 1); }
    const int kvh = hq >> 1;
    fa::Item I; I.qkv = F.big; I.O = F.hbuf2; I.lse = F.lse; I.seq_base = seq_base; I.two = 0; I.dil = 1; I.c0 = 0; I.SU = S; I.u0 = 256 * qb; I.hh = 0; I.ukb0 = 0; I.NT = S / 64;
    I.W = 4096; I.qcol = hq * 256; I.kcol = 2048 + kvh * 256; I.vcol = 3072 + kvh * 256; I.ocol = hq * 256;
    I.nslope = -exp2f(-(float)(hq + 1)) * LOG2E; I.sink2 = 0.f; I.nlam = nlam; I.subg = subg;
    I.kmax2 = (const float*)(F.ws + WS_KMAX) + batch_of(seq_base) * 8 + kvh * 2;
    fa::attn_item_c<0>(I, (char*)F.lds, F.tid);
    I.qcol += 128; I.kcol += 128; I.kmax2 += 1;
    fa::attn_item_c<3>(I, (char*)F.lds, F.tid);
  }
}
__device__ __forceinline__ void phase_subln(const Frame& F0) {
  const Frame F = fresh(F0);
  const int k32 = F.lane & 31, half = F.lane >> 5;
  const float* sg = argp(F, 17) + 8 * k32;
  float g[8];
#pragma unroll
  for (int e = 0; e < 8; ++e) g[e] = sg[e] * (1.f - LAM_INIT2);
  for (int T = F.gw; T < TOK; T += F.NGW) {
    u32x4 raws[4];
#pragma unroll
    for (int it = 0; it < 4; ++it) raws[it] = LDG(u32x4, F.hbuf2 + (size_t)T * DM + (it * 2 + half) * 256 + 8 * k32);
    asm volatile("" ::: "memory");
#pragma unroll
    for (int it = 0; it < 4; ++it) { bf16_t* p = F.hbuf2 + (size_t)T * DM + (it * 2 + half) * 256 + 8 * k32;
      const u32x4 raw = raws[it];
      float x[8] = {bf_lo(raw.x), bf_hi(raw.x), bf_lo(raw.y), bf_hi(raw.y), bf_lo(raw.z), bf_hi(raw.z), bf_lo(raw.w), bf_hi(raw.w)};
      float ss = 0.f;
#pragma unroll
      for (int e = 0; e < 8; ++e) ss += x[e] * x[e];
      ss += swz_xor<1>(ss); ss += swz_xor<2>(ss); ss += swz_xor<4>(ss); ss += swz_xor<8>(ss); ss += swz_xor<16>(ss);
      const float rstd = 1.0f / sqrtf(ss * (1.f / 256.f) + EPS);
      u32x4 w; w.x = cvt_pk_bf16(x[0] * rstd * g[0], x[1] * rstd * g[1]); w.y = cvt_pk_bf16(x[2] * rstd * g[2], x[3] * rstd * g[3]);
      w.z = cvt_pk_bf16(x[4] * rstd * g[4], x[5] * rstd * g[5]); w.w = cvt_pk_bf16(x[6] * rstd * g[6], x[7] * rstd * g[7]);
      STG(u32x4, p) = w; }
  }
}

__device__ __forceinline__ Frame mkframe(LAS unsigned char* lds, int wave0) {
    Frame F; F.lds = lds;
    int tid = (wave0 << 6) | lane_id(); asm volatile("" : "+v"(tid));
    F.tid = tid; F.lane = tid & 63; F.wave = __builtin_amdgcn_readfirstlane(tid >> 6);
    int G = gridDim.x, bx = blockIdx.x; asm volatile("" : "+s"(G), "+s"(bx));
    F.G = G; F.vcu = (G % 8 == 0) ? (bx % 8) * (G / 8) + bx / 8 : bx;
    F.gw = F.vcu * NWAVES + F.wave; F.NGW = G * NWAVES;
    unsigned long long ka = (unsigned long long)__builtin_amdgcn_kernarg_segment_ptr(); asm volatile("" : "+s"(ka));
    F.kargs = ka;
    F.out = ((float* const __attribute__((address_space(4)))*)ka)[26]; unsigned char* ws = ((unsigned char* const __attribute__((address_space(4)))*)ka)[27];
    F.ws = ws; F.hbuf = (bf16_t*)(ws + WS_H) + (size_t)256 * DM; F.big = (bf16_t*)(ws + WS_BIG); F.mod = (float*)(ws + WS_MOD); F.lse = (float*)(ws + WS_LSE);
    F.hbuf2 = (bf16_t*)(ws + WS_H2); F.ssq = (float*)(ws + WS_SSQ); F.bias = (float*)(ws + WS_BIAS); F.xb = (bf16_t*)(ws + WS_XB);
    return F; }
__global__ void __launch_bounds__(NTHREADS, 2) fwd(Args args) {
    extern __shared__ __attribute__((aligned(16))) unsigned char lds_raw[];
    LAS unsigned char* const ldsb = (LAS unsigned char*)lds_raw;
    volatile LAS unsigned* MISC = (volatile LAS unsigned*)(ldsb + MISC_OFF);
    const int wave0 = __builtin_amdgcn_readfirstlane((int)threadIdx.x >> 6);
    if (threadIdx.x < 32) MISC[threadIdx.x] = 0u;
    __syncthreads();
    unsigned* barw = (unsigned*)(args.ws + WS_CTL) + CW_BAR;
    XcdBarrier bar; bar.bar = barw; bar.x = 0; bar.st = nullptr; bar.w0 = (unsigned)wave0;
    if (!MK_MULTI) bar = xcd_barrier_post(barw, MISC + 8, (unsigned)wave0);
    const int lo = args.ph_lo, hi = args.ph_hi;
#ifndef PHSEL
#define PHSEL(k) 1
#endif
#define IN(k) (PHSEL(k) && ({ int lo_ = lo, hi_ = hi; asm volatile("" : "+s"(lo_), "+s"(hi_)); lo_ <= (k) && (k) < hi_; }))
#define SEAM(k) do { if (!MK_MULTI) xcd_barrier(bar); } while (0)

    const bool SPREAD = (gridDim.x == 256);
    if (IN(0)) { phase_ropetab(mkframe(ldsb, wave0)); for (int rp = 0; rp < REPS(0); ++rp) { phase_mod(mkframe(ldsb, wave0)); __syncthreads(); phase_weights(mkframe(ldsb, wave0), SPREAD ? 9 : 15, 0, 0); __syncthreads(); } SEAM(0); }

    for (int L0 = 0; L0 < 4; ++L0) {
        const int pb = 1 + 10 * L0;
#define LAYER_VARS() const Frame P = mkframe(ldsb, wave0); int L = L0; asm volatile("" : "+s"(L)); const float* modl = P.mod + (size_t)L * NB * 6 * DM; \
        const float* xin_p = (L == 0) ? argp(P, 0) : P.out; const float* xin_s = (L == 0) ? argp(P, 1) - (size_t)TOKP * DM : P.out; const int NQ = (L == 2) ? 4096 : 3072; (void)modl; (void)xin_p; (void)xin_s; (void)NQ
        if (L0 == 0 && IN(pb + 0)) { LAYER_VARS(); for (int rp = 0; rp < REPS(1); ++rp) { phase_bias(P, SPREAD ? 9 : 15, 0, 0); phase_norm0(P, xin_p, xin_s, argp(P, 4), modl, 1, P.ssq); } SEAM(pb + 0); }
        if (IN(pb + 1)) { LAYER_VARS();
            pg8::Gemm g{P.hbuf, wt_ptr(P, L, WT_QKV), DM}; pg8::StaticOrder S; S.init(TOK / 256, NQ / 256, P.G, (int)blockIdx.x);
            pg8::EpiQKV E{P.big, NQ, 2048, (L == 0) ? 1.0f : QSCALE, P.ssq + (size_t)(2 * L) * SSQ_STRIDE, P.bias + (size_t)L * BIAS_L};
            for (int rp = 0; rp < REPS(2); ++rp) pg8::gemm_phase<pg8::EpiQKV, 0>(P.lds, g, S, E, STAG_QKV, P.tid);
            if (SPREAD && L < 2 && (int)blockIdx.x >= 128) { __syncthreads(); phase_weights(mkframe(ldsb, wave0), 2 << L, 128, 128); }
            SEAM(pb + 1);
        }
        if (L0 == 0) {
            if (IN(pb + 2)) { { const Frame P = mkframe(ldsb, wave0); phase_qknorm_rope<!NAIVE_A>(P, argp(P, 9), argp(P, 10)); } SEAM(pb + 2); }
#if NAIVE_A
            if (IN(pb + 3)) { phase_attn_naive<0>(mkframe(ldsb, wave0)); SEAM(pb + 3); }
#else
            if (IN(pb + 3)) { for (int rp = 0; rp < REPS(3) + REPS(6) - 1; ++rp) phase_attn_fast<0>(mkframe(ldsb, wave0)); SEAM(pb + 3); }
#endif
        } else if (L0 == 1) {
#if NAIVE_B
            if (IN(pb + 2)) { phase_attn_naive<1>(mkframe(ldsb, wave0)); SEAM(pb + 2); }
#else
            if (IN(pb + 2)) { for (int rp = 0; rp < REPS(3) + REPS(7) - 1; ++rp) phase_attn_fast<1>(mkframe(ldsb, wave0)); SEAM(pb + 2); }
#endif
        } else if (L0 == 2) {
#if NAIVE_C
            if (IN(pb + 2)) { phase_attn_naive<2>(mkframe(ldsb, wave0)); SEAM(pb + 2); }
#else
            if (IN(pb + 2)) { phase_kmax(mkframe(ldsb, wave0)); SEAM(pb + 2); for (int rp = 0; rp < REPS(3) + REPS(8) - 1; ++rp) phase_attn_c(mkframe(ldsb, wave0)); SEAM(pb + 2); }
#endif
        } else {
#if NAIVE_D
            if (IN(pb + 2)) { phase_attn_naive<3>(mkframe(ldsb, wave0)); SEAM(pb + 2); }
#else
            if (IN(pb + 2)) { for (int rp = 0; rp < REPS(3) + REPS(9) - 1; ++rp) phase_attn_fast<4>(mkframe(ldsb, wave0)); SEAM(pb + 2); }
            if (IN(pb + 3)) { phase_attn_fast<5>(mkframe(ldsb, wave0)); SEAM(pb + 3); }
            if (IN(pb + 4)) { phase_attn_fast<6>(mkframe(ldsb, wave0)); SEAM(pb + 4); }
#endif
        }
        if (IN(pb + 5)) { LAYER_VARS();
            pg8::Gemm g{P.hbuf2, wt_ptr(P, L, WT_WO), DM}; pg8::StaticOrder S; S.init(TOK / 256, DM / 256, P.G, (int)blockIdx.x);
            pg8::EpiRes<true> E{xin_p, xin_s, P.out, modl + 2 * DM, P.xb, P.hbuf, argp(P, 5) + L * DM, modl + 4 * DM, P.ssq + (size_t)(2 * L + 1) * SSQ_STRIDE};
            pg8::gemm_phase<pg8::EpiRes<true>, 0>(P.lds, g, S, E, STAG_WO, P.tid);
            SEAM(pb + 5);
        }
        if (IN(pb + 7)) { LAYER_VARS();
            pg8::Gemm g{P.hbuf, wt_ptr(P, L, WT_UP), DM}; pg8::StaticOrder S; S.init(163, DFF / 128, P.G, (int)blockIdx.x);
            pg8::EpiGLU E{P.big, argp(P, 22) + (size_t)L * 3 * DFF, argp(P, 23) + (size_t)L * DFF, P.ssq + (size_t)(2 * L + 1) * SSQ_STRIDE, P.bias + (size_t)L * BIAS_L + 12 * 4096};
            if (REPS(11) == 2) { pg8::EpiNull E0; pg8::gemm_phase<pg8::EpiNull, 1>(P.lds, g, S, E0, 0, P.tid); }
            for (int rp = 0; rp < REPS(5); ++rp) pg8::gemm_phase<pg8::EpiGLU, 1>(P.lds, g, S, E, STAG_UP, P.tid);
            if (SPREAD && L < 2 && (int)blockIdx.x >= 97) { __syncthreads(); phase_bias(mkframe(ldsb, wave0), 2 << L, 97, 159); }
            SEAM(pb + 7);
        }
        if (IN(pb + 8)) { LAYER_VARS();
            pg8::Gemm g{P.big, wt_ptr(P, L, WT_DOWN), DFF}; pg8::StaticOrder S; S.init(TOK / 256, DM / 256, P.G, (int)blockIdx.x, 4);
            if (L < 3) { pg8::EpiRes<true> E{P.out, P.out, P.out, modl + 5 * DM, P.xb, P.hbuf, argp(P, 4) + (L + 1) * DM, modl + NB * 6 * DM + 1 * DM, P.ssq + (size_t)(2 * L + 2) * SSQ_STRIDE};
                pg8::gemm_phase<pg8::EpiRes<true>, 0>(P.lds, g, S, E, STAG_DOWN, P.tid); }
            else { pg8::EpiRes<false> E{P.out, P.out, P.out, modl + 5 * DM, P.xb, nullptr, nullptr, nullptr, nullptr};
                pg8::gemm_phase<pg8::EpiRes<false>, 0>(P.lds, g, S, E, STAG_DOWN, P.tid); }
            SEAM(pb + 8);
        }
#undef LAYER_VARS
    }
    if (IN(41)) { const Frame P = mkframe(ldsb, wave0); phase_final_norm(P, argp(P, 25)); }
#undef IN
#undef SEAM
}

extern "C" void kernel_launch(void* const* d_in, const int* in_sizes, int n_in, void* d_out, int out_size, void* d_ws, size_t ws_size, hipStream_t stream) {
    static int grid = 0;
    if (grid == 0) {
        if (n_in != 26 || out_size != TOK * DM || ws_size < WS_END) { fprintf(stderr, "kernel_launch: unexpected shapes (n_in %d out %d ws %zu)\n", n_in, out_size, ws_size); grid = -1; return; }
        int dev = 0, cus = 0, per_cu = 0;
        if (hipGetDevice(&dev) != hipSuccess || hipDeviceGetAttribute(&cus, hipDeviceAttributeMultiprocessorCount, dev) != hipSuccess) { grid = -1; return; }
        if (hipFuncSetAttribute((const void*)fwd, hipFuncAttributeMaxDynamicSharedMemorySize, LDS_BYTES) != hipSuccess) { fprintf(stderr, "kernel_launch: hipFuncSetAttribute failed\n"); grid = -1; return; }
        if (hipOccupancyMaxActiveBlocksPerMultiprocessor(&per_cu, (const void*)fwd, NTHREADS, LDS_BYTES) != hipSuccess || per_cu < 1) fprintf(stderr, "kernel_launch: occupancy query says %d\n", per_cu);
        (void)hipGetLastError();
        grid = cus;
    }
    if (grid < 0) return;
    (void)hipMemsetAsync((char*)d_ws + WS_CTL, 0, CTL_ZERO_BYTES, stream);
    Args a{};
    for (int i = 0; i < 26; ++i) a.in[i] = (const float*)d_in[i];
    a.out = (float*)d_out; a.ws = (unsigned char*)d_ws;
#if MK_MULTI
    for (int p = 0; p < 42; ++p) {
        const int r = (p - 1) % 10, L = (p - 1) / 10;
        if (p >= 1 && p <= 40) { if (r == 9 || r == 6 || (r == 0 && L != 0)) continue; if (r == 4 && !(L == 3 && !NAIVE_D)) continue; if (r == 3 && !(L == 0 || (L == 3 && !NAIVE_D))) continue; }
        a.ph_lo = p; a.ph_hi = p + 1;
        hipLaunchKernelGGL(fwd, dim3(grid), dim3(NTHREADS), LDS_BYTES, stream, a);
    }
#else
    a.ph_lo = 0; a.ph_hi = 42;
    hipLaunchKernelGGL(fwd, dim3(grid), dim3(NTHREADS), LDS_BYTES, stream, a);
#endif
}
```

```cpp
#include <hip/hip_runtime.h>
#include <cstdio>
#include <cstdint>

#ifndef MK_MULTI
#define MK_MULTI 0
#endif
#ifndef NAIVE_A
#define NAIVE_A 0
#endif
#ifndef NAIVE_B
#define NAIVE_B 0
#endif
#ifndef NAIVE_C
#define NAIVE_C 0
#endif
#ifndef NAIVE_D
#define NAIVE_D 0
#endif

#ifndef PROBE_MASK
#define PROBE_MASK 0
#endif
#define REPS(k) (((PROBE_MASK >> (k)) & 1) ? 2 : 1)
#ifndef STAG_QKV
#define STAG_QKV 0
#endif
#ifndef STAG_WO
#define STAG_WO 0
#endif
#ifndef STAG_UP
#define STAG_UP 0
#endif
#ifndef STAG_DOWN
#define STAG_DOWN 0
#endif
#ifndef RES_BF16
#define RES_BF16 0
#endif
#define LAS __attribute__((address_space(3)))
#define GAS __attribute__((address_space(1)))
#define LDG(T, p) (*(const GAS T*)(p))
#define STG(T, p) (*(GAS T*)(p))
typedef unsigned short bf16_t;
typedef short bf16x8 __attribute__((ext_vector_type(8)));
typedef float f32x4 __attribute__((ext_vector_type(4)));
typedef float f32x2 __attribute__((ext_vector_type(2)));
typedef unsigned u32x4 __attribute__((ext_vector_type(4)));
typedef unsigned u32x2 __attribute__((ext_vector_type(2)));

constexpr int DM = 2048, TOKP = 8192, TOKS = 32768, TOK = TOKP + TOKS, DFF = 5504, NB = 12;
constexpr int SP_ = 2048, SS_ = 4096;
constexpr float EPS = 1e-6f, LOG2E = 1.4426950408889634f;
constexpr float QSCALE = 0.08838834764831845f * LOG2E;
constexpr float LAM_INIT2 = 0.47071301834358826f;
constexpr int NWAVES = 8, NTHREADS = 512;

constexpr size_t MiB = 1u << 20;
constexpr size_t WS_CTL = 0, CTL_ZERO_BYTES = 3 * MiB;
constexpr size_t WS_SSQ = 1 * MiB;
constexpr size_t WS_MOD = 3 * MiB;
constexpr size_t WS_LSE = 6 * MiB;
constexpr size_t WS_BIAS = 9 * MiB;
constexpr size_t WS_WT = 12 * MiB;
constexpr size_t LWT = 92798976;
constexpr size_t WT_QKV = 0, WT_WO = 16 * MiB, WT_UP = 24 * MiB, WT_DOWN = 67 * MiB;
constexpr size_t WS_H = 368 * MiB;
constexpr size_t WS_BIG = 532 * MiB;
constexpr size_t WS_H2 = 964 * MiB;
constexpr size_t WS_XB = 1128 * MiB;
constexpr size_t WS_END = 1292 * MiB;
constexpr int SSQ_STRIDE = TOK + 256, BIAS_L = 12 * (4096 + 2 * DFF);
static_assert(WS_SSQ + 8 * (size_t)SSQ_STRIDE * 4 <= WS_MOD && WS_BIAS + 4 * (size_t)BIAS_L * 4 <= WS_WT && WS_WT + 4 * LWT <= WS_H && WS_H + (size_t)(TOK + 512) * DM * 2 <= WS_BIG && WS_BIG + (size_t)TOK * DFF * 2 <= WS_H2 && WS_H2 + (size_t)TOK * DM * 2 <= WS_XB && WS_XB + (size_t)TOK * DM * 2 <= WS_END, "ws map");
constexpr size_t WS_KMAX = 65536;
constexpr size_t WS_ROPE = WS_KMAX + 4096;
constexpr size_t WS_CQ = WS_KMAX + 1024;
constexpr int CW_BAR = 4096;

constexpr int RING_BYTES = 131072, MISC_OFF = 139264, LDS_BYTES = 147456;

__device__ __forceinline__ unsigned cvt_pk_bf16(float lo, float hi) { unsigned r; asm volatile("v_cvt_pk_bf16_f32 %0, %1, %2" : "=v"(r) : "v"(lo), "v"(hi)); return r; }
__device__ __forceinline__ float bf_lo(unsigned w) { return __uint_as_float(w << 16); }
__device__ __forceinline__ float bf_hi(unsigned w) { return __uint_as_float(w & 0xffff0000u); }
template <int O> __device__ __forceinline__ float swz_xor(float v) { return __int_as_float(__builtin_amdgcn_ds_swizzle(__float_as_int(v), (O << 10) | 0x1F)); }
__device__ __forceinline__ float wave_sum(float v) {
    v += swz_xor<1>(v); v += swz_xor<2>(v); v += swz_xor<4>(v); v += swz_xor<8>(v); v += swz_xor<16>(v);
    auto rr = __builtin_amdgcn_permlane32_swap(__float_as_uint(v), __float_as_uint(v), false, false); return __uint_as_float(rr[0]) + __uint_as_float(rr[1]); }
__device__ __forceinline__ float wave_max(float v) {
    v = fmaxf(v, swz_xor<1>(v)); v = fmaxf(v, swz_xor<2>(v)); v = fmaxf(v, swz_xor<4>(v)); v = fmaxf(v, swz_xor<8>(v)); v = fmaxf(v, swz_xor<16>(v));
    auto rr = __builtin_amdgcn_permlane32_swap(__float_as_uint(v), __float_as_uint(v), false, false); return fmaxf(__uint_as_float(rr[0]), __uint_as_float(rr[1])); }
__device__ __forceinline__ float bperm(float v, int src_byte) { return __int_as_float(__builtin_amdgcn_ds_bpermute(src_byte, __float_as_int(v))); }
__device__ __forceinline__ int seq_len_of(int T) { return T < TOKP ? SP_ : SS_; }
__device__ __forceinline__ int batch_of(int T) { return T < TOKP ? (T >> 11) : 4 + ((T - TOKP) >> 12); }

__device__ __forceinline__ int lane_id() { int l; asm volatile("v_mbcnt_lo_u32_b32 %0, -1, 0\n\tv_mbcnt_hi_u32_b32 %0, -1, %0" : "=v"(l)); return l; }
#define XB_TMO      128
#define XB_XCNT(j)  (256  + 64 * (j))
#define XB_XSUB(j)  (1280 + 64 * (j))
#define XB_XGEN(j)  (2304 + 64 * (j))
#define XB_TOP      3328
#define XB_TOPGEN   3392
#define XCD_BAR_WORDS 3456
#define XB_SPIN_CAP (1u << 22)
__device__ __forceinline__ unsigned xb_ld(unsigned* p)              { return __hip_atomic_load(p, __ATOMIC_RELAXED, __HIP_MEMORY_SCOPE_AGENT); }
__device__ __forceinline__ unsigned xb_add(unsigned* p, unsigned v) { return __hip_atomic_fetch_add(p, v, __ATOMIC_RELAXED, __HIP_MEMORY_SCOPE_AGENT); }
__device__ __forceinline__ unsigned xb_xcc_id() { return (unsigned)__builtin_amdgcn_s_getreg((3 << 11) | 20) & 0xFu; }
#define XB_SPIN(cond, bar) do { unsigned _sp = 0; while (cond) { __builtin_amdgcn_s_sleep(1); \
    if ((++_sp & 255u) == 0u) { if (xb_ld(&(bar)[XB_TMO])) break; if (_sp > XB_SPIN_CAP) { atomicAdd(&(bar)[XB_TMO], 1u); break; } } } } while (0)
struct XcdBarrier { unsigned* bar; unsigned x; volatile LAS unsigned* st; unsigned w0; };
__device__ __forceinline__ XcdBarrier xcd_barrier_post(unsigned* bar, volatile LAS unsigned* st, unsigned w0) {
    XcdBarrier b; b.bar = bar; b.x = xb_xcc_id(); b.st = st; b.w0 = w0;
    if (w0 == 0u && lane_id() == 0) (void)xb_add(&bar[XB_XCNT(b.x)], 1u);
    return b;
}
__device__ __forceinline__ void xcd_barrier_complete(unsigned* bar, unsigned x, unsigned& nloc, unsigned& nx) {
    const unsigned G = gridDim.x * gridDim.y * gridDim.z;
    unsigned sum, cnt, mine, sp = 0u;
    for (;;) {
        sum = 0u; cnt = 0u; mine = 0u;
#pragma unroll
        for (unsigned j = 0; j < 16; ++j) { const unsigned c = xb_ld(&bar[XB_XCNT(j)]); sum += c; cnt += (c > 0u) ? 1u : 0u; mine = (j == x) ? c : mine; }
        if (sum == G) break;
        __builtin_amdgcn_s_sleep(1);
        if ((++sp & 255u) == 0u) { if (xb_ld(&bar[XB_TMO])) break; if (sp > XB_SPIN_CAP) { atomicAdd(&bar[XB_TMO], 1u); break; } }
    }
    nloc = mine > 0u ? mine : 1u; nx = cnt > 0u ? cnt : 1u;
}
__device__ __forceinline__ void xcd_barrier(const XcdBarrier& b) {
    asm volatile("s_waitcnt vmcnt(0)" ::: "memory");
    __syncthreads();
    if (b.w0 == 0u && lane_id() == 0) {
        unsigned* bar = b.bar;
        __builtin_amdgcn_s_waitcnt(0);
        unsigned nloc = b.st[0], nx = b.st[1];
        if (nloc == 0u) { xcd_barrier_complete(bar, b.x, nloc, nx); b.st[0] = nloc; b.st[1] = nx; }
        const unsigned old = xb_add(&bar[XB_XSUB(b.x)], 1u);
        const unsigned gen = old / nloc;
        if (old + 1u == (gen + 1u) * nloc) {
            __builtin_amdgcn_fence(__ATOMIC_RELEASE, "agent");
            asm volatile("s_waitcnt vmcnt(0)" ::: "memory");
            const unsigned og = xb_add(&bar[XB_TOP], 1u);
            const unsigned tg = og / nx;
            if (og + 1u == (tg + 1u) * nx) xb_add(&bar[XB_TOPGEN], 1u);
            else XB_SPIN(xb_ld(&bar[XB_TOPGEN]) == tg, bar);
            __builtin_amdgcn_fence(__ATOMIC_ACQUIRE, "agent");
            xb_add(&bar[XB_XGEN(b.x)], 1u);
            asm volatile("s_waitcnt vmcnt(0)" ::: "memory");
        } else {
            XB_SPIN(xb_ld(&bar[XB_XGEN(b.x)]) == gen, bar);
            __builtin_amdgcn_fence(__ATOMIC_ACQUIRE, "agent");
            asm volatile("s_waitcnt vmcnt(0)" ::: "memory");
        }
    }
    __syncthreads();
}

namespace pg8 {
constexpr int BM = 256, BK = 64, HALF = 128, HTB = HALF * BK * 2, STAGE_BYTES = 8 * HTB, NXCD = 8, WGM = 8;
__host__ __device__ __forceinline__ int lds_byte(int r, int c) { const int st = (r >> 4) * 2 + (c >> 5), rr = r & 15, cc = c & 31, ob = rr * 64 + cc * 2; return st * 1024 + (ob ^ (((ob >> 9) & 1) << 5)); }
__host__ __device__ __forceinline__ void stage_rc(int b, int& R, int& C) { const int st = b / 1024, sb = b % 1024, swz = sb ^ (((sb >> 9) & 1) << 5); R = (st >> 1) * 16 + swz / 64; C = (st & 1) * 32 + (swz % 64) / 2; }
__host__ __device__ __forceinline__ int perm32(int rho) { const int n = rho >> 4, i = rho & 15; return 8 * (i >> 2) + 4 * n + (i & 3); }
struct Unit { int pm, pn; };
struct Gemm { const bf16_t* A; const bf16_t* Bt; int K; };
struct StaticOrder {
    int nM, nN, nwg, G, c, wgm;
    __device__ void init(int nM_, int nN_, int G_, int c_, int wgm_ = WGM) { nM = nM_; nN = nN_; nwg = nM * nN; G = G_; c = c_; wgm = wgm_; }
    __device__ bool next(int i, Unit& u) const {
        const long L = (long)i * G + c; if (L >= nwg) return false;
        int wgid = (int)L; { const int q = nwg / NXCD, r = nwg % NXCD, xcd = wgid % NXCD, off = wgid / NXCD; wgid = (xcd < r ? xcd * (q + 1) : r * (q + 1) + (xcd - r) * q) + off; }
        const int nig = wgm * nN, gid = wgid / nig, fm = gid * wgm, gsz = (nM - fm) < wgm ? (nM - fm) : wgm;
        u.pm = fm + ((wgid % nig) % gsz); u.pn = (wgid % nig) / gsz; return true;
    }
};
template <class Epi, int AMODE>
__device__ __forceinline__ void gemm_phase(LAS unsigned char* lds, const Gemm g, const StaticOrder& S, const Epi& E, int stagger_us, int tid_in) {
    int tid = tid_in; asm volatile("" : "+v"(tid));
    const int wid = __builtin_amdgcn_readfirstlane(tid >> 6), lane = tid & 63, wr = wid >> 2, wc = wid & 3, fr = lane & 15, fq = lane >> 4;
    const int K = g.K, nt = K / BK;
    unsigned voffA[2], voffB[2];
#pragma unroll
    for (int i = 0; i < 2; ++i) { int R, C; stage_rc(tid * 16 + i * 8192, R, C); const int Rb = Epi::PERM ? ((R & ~31) + perm32(R & 31)) : R;
        const int Ra = AMODE == 1 ? (126 * (R >> 6) + 8 * (R & 15) + ((R >> 4) & 3)) : R;
        voffA[i] = (unsigned)(Ra * K + C) * 2u; voffB[i] = (unsigned)(Rb * K + C) * 2u; }
    const size_t kstep = (size_t)(BK * 2);
    const size_t hstepB = (size_t)HALF * K * 2, tstepB = 2 * hstepB;
    const size_t hstepA = AMODE == 1 ? (size_t)4 * K * 2 : hstepB, tstepA = AMODE == 1 ? (size_t)252 * K * 2 : tstepB;
    const char* Abase = (const char*)g.A - (AMODE == 1 ? (size_t)K * 2 : 0);
    const unsigned ldsw = (unsigned)wid * 1024u;
    const int aoff = lds_byte(wr * 64 + fr, fq * 8), boff = lds_byte(wc * 32 + fr, fq * 8);
#define PG8_SA(b, h) (((b) * 2 + (h)) * HTB)
#define PG8_SB(b, h) ((4 + (b) * 2 + (h)) * HTB)
#define PG8_STAGE(bufoff, gbase, voff) do { _Pragma("unroll") for (int _i = 0; _i < 2; ++_i) \
        __builtin_amdgcn_global_load_lds((const unsigned*)((const char*)(gbase) + (voff)[_i]), (LAS unsigned*)(lds + (bufoff) + ldsw + _i * 8192), 16, 0, 0); } while (0)
#define PG8_LDA(dst, b, h) do { _Pragma("unroll") for (int m = 0; m < 4; ++m) _Pragma("unroll") for (int k = 0; k < 2; ++k) dst[m][k] = *(const LAS bf16x8*)(lds + PG8_SA(b, h) + aoff + m * 2048 + k * 1024); } while (0)
#define PG8_LDB(dst, b, h) do { _Pragma("unroll") for (int n = 0; n < 2; ++n) _Pragma("unroll") for (int k = 0; k < 2; ++k) dst[n][k] = *(const LAS bf16x8*)(lds + PG8_SB(b, h) + boff + n * 2048 + k * 1024); } while (0)
#define PG8_MMA(ai, bj, At, Bt) do { __builtin_amdgcn_s_setprio(1); _Pragma("unroll") for (int m = 0; m < 4; ++m) _Pragma("unroll") for (int n = 0; n < 2; ++n) _Pragma("unroll") for (int k = 0; k < 2; ++k) \
        acc[ai][bj][m][n] = __builtin_amdgcn_mfma_f32_16x16x32_bf16(Bt[n][k], At[m][k], acc[ai][bj][m][n], 0, 0, 0); __builtin_amdgcn_s_setprio(0); } while (0)
#define PG8_WAIT_V(n) asm volatile("s_waitcnt vmcnt(" #n ")" ::: "memory")
#define PG8_WAIT_L(n) asm volatile("s_waitcnt lgkmcnt(" #n ")" ::: "memory")
#define PG8_BAR __builtin_amdgcn_s_barrier()
#define PG8_SCHED __builtin_amdgcn_sched_barrier(0)
    Unit cur, nxt; int ui = 0;
    if (!S.next(0, cur)) return;
    if (stagger_us > 0) { const unsigned long long ticks = (unsigned long long)(stagger_us * 100) * (unsigned)S.c / (unsigned)S.G, t0 = __builtin_amdgcn_s_memrealtime();
        while (__builtin_amdgcn_s_memrealtime() - t0 < ticks) __builtin_amdgcn_s_sleep(8); }
    f32x4 acc[2][2][4][2];
#pragma unroll
    for (int a = 0; a < 2; ++a)
#pragma unroll
        for (int b = 0; b < 2; ++b)
#pragma unroll
            for (int m = 0; m < 4; ++m)
#pragma unroll
                for (int n = 0; n < 2; ++n) acc[a][b][m][n] = (f32x4){0.f, 0.f, 0.f, 0.f};
    bf16x8 At[4][2], B0[2][2], B1[2][2];
    const char* cA = Abase + (size_t)cur.pm * tstepA; const char* cB = (const char*)g.Bt + (size_t)cur.pn * tstepB;
    PG8_STAGE(PG8_SB(0, 0), cB, voffB); PG8_STAGE(PG8_SB(0, 1), cB + hstepB, voffB); PG8_STAGE(PG8_SA(0, 0), cA, voffA); PG8_STAGE(PG8_SA(0, 1), cA + hstepA, voffA);
    if (wr == 1) PG8_BAR;
    PG8_WAIT_V(2); PG8_BAR;
    PG8_STAGE(PG8_SB(1, 0), cB + kstep, voffB); PG8_STAGE(PG8_SA(1, 0), cA + kstep, voffA); PG8_STAGE(PG8_SB(1, 1), cB + hstepB + kstep, voffB);
    PG8_WAIT_V(6); PG8_BAR;
    for (;;) {
        const bool has_next = S.next(ui + 1, nxt);
        const char* nA = has_next ? Abase + (size_t)nxt.pm * tstepA : cA; const char* nB = has_next ? (const char*)g.Bt + (size_t)nxt.pn * tstepB : cB;
        for (int t = 0; t < nt; t += 2) {
            const bool last = (t == nt - 2);
            const char* a1 = cA + (size_t)(t + 1) * kstep;
            const char* a2 = last ? nA : cA + (size_t)(t + 2) * kstep; const char* b2 = last ? nB : cB + (size_t)(t + 2) * kstep;
            const char* a3 = a2 + kstep; const char* b3 = b2 + kstep;
            PG8_LDB(B0, 0, 0); PG8_LDB(B1, 0, 1); PG8_SCHED; PG8_LDA(At, 0, 0); PG8_STAGE(PG8_SA(1, 1), a1 + hstepA, voffA);
            PG8_WAIT_V(8); PG8_WAIT_L(0); PG8_BAR; PG8_MMA(0, 0, At, B0); PG8_MMA(0, 1, At, B1); PG8_BAR; PG8_SCHED;
            PG8_LDA(At, 0, 1); PG8_STAGE(PG8_SB(0, 0), b2, voffB); PG8_STAGE(PG8_SB(0, 1), b2 + hstepB, voffB); PG8_STAGE(PG8_SA(0, 0), a2, voffA);
            PG8_WAIT_V(8); PG8_WAIT_L(0); PG8_BAR; PG8_MMA(1, 0, At, B0); PG8_MMA(1, 1, At, B1); PG8_BAR; PG8_SCHED;
            PG8_LDB(B0, 1, 0); PG8_LDB(B1, 1, 1); PG8_SCHED; PG8_LDA(At, 1, 0); PG8_STAGE(PG8_SA(0, 1), a2 + hstepA, voffA);
            PG8_WAIT_V(8); PG8_WAIT_L(0); PG8_BAR; PG8_MMA(0, 0, At, B0); PG8_MMA(0, 1, At, B1); PG8_BAR; PG8_SCHED;
            PG8_LDA(At, 1, 1); PG8_STAGE(PG8_SB(1, 0), b3, voffB); PG8_STAGE(PG8_SB(1, 1), b3 + hstepB, voffB); PG8_STAGE(PG8_SA(1, 0), a3, voffA);
            PG8_WAIT_V(8); PG8_WAIT_L(0); PG8_BAR; PG8_MMA(1, 0, At, B0); PG8_MMA(1, 1, At, B1); PG8_BAR; PG8_SCHED;
        }
        if (wr == 0) PG8_BAR;
        E(acc, cur, wr, wc, fr, fq);
        if (!has_next) break;
#pragma unroll
        for (int a = 0; a < 2; ++a)
#pragma unroll
            for (int b = 0; b < 2; ++b)
#pragma unroll
                for (int m = 0; m < 4; ++m)
#pragma unroll
                    for (int n = 0; n < 2; ++n) acc[a][b][m][n] = (f32x4){0.f, 0.f, 0.f, 0.f};
        cur = nxt; cA = nA; cB = nB; ++ui;
        if (wr == 1) PG8_BAR;
    }
    PG8_WAIT_V(0);
    PG8_BAR;
#undef PG8_SA
#undef PG8_SB
#undef PG8_STAGE
#undef PG8_LDA
#undef PG8_LDB
#undef PG8_MMA
#undef PG8_WAIT_V
#undef PG8_WAIT_L
#undef PG8_BAR
#undef PG8_SCHED
}

__device__ __forceinline__ f32x2 gelu_pk(f32x2 v) {
    const f32x2 av = __builtin_elementwise_abs(v), d = av * 0.2316418882f + 1.0f;
    f32x2 t; t.x = __builtin_amdgcn_rcpf(d.x); t.y = __builtin_amdgcn_rcpf(d.y);
    f32x2 q = t * 0.5307027145f + (-0.7265760135f); q = q * t + 0.7107068705f; q = q * t + (-0.142248368f); q = q * t + 0.127414796f; q = q * t;
    const f32x2 s = (v * v) * (-0.72134752044f);
    f32x2 e; e.x = __builtin_amdgcn_exp2f(s.x); e.y = __builtin_amdgcn_exp2f(s.y);
    const f32x2 h = 0.5f - q * e;
    return av * h + v * 0.5f;
}

__device__ __forceinline__ float rstd_of(const float* ssq, int row) { return 1.0f / sqrtf(LDG(float, ssq + row) * (1.f / DM) + EPS); }
struct EpiQKV {
    static constexpr bool PERM = true;
    bf16_t* O; int ldc; int qcols; float qscale; const float* ssq; const float* bias;
    __device__ __forceinline__ void operator()(const f32x4 (&acc)[2][2][4][2], const Unit& u, int wr, int wc, int fr, int fq) const {
        const int row0 = u.pm * BM + wr * 64 + fr; const int col0 = u.pn * BM + wc * 32 + 8 * fq;
        const float sc = (u.pn * BM < qcols) ? qscale : 1.f;
        const float* bp = bias + (size_t)batch_of(u.pm * BM) * ldc + col0;
        f32x4 bv[2][2]; float sq[8];
#pragma unroll
        for (int am = 0; am < 8; ++am) sq[am] = LDG(float, ssq + row0 + (am >> 2) * HALF + (am & 3) * 16);
#pragma unroll
        for (int bj = 0; bj < 2; ++bj)
#pragma unroll
            for (int n = 0; n < 2; ++n) bv[bj][n] = LDG(f32x4, bp + bj * HALF + 4 * n) * sc;
#pragma unroll
        for (int ai = 0; ai < 2; ++ai)
#pragma unroll
            for (int m = 0; m < 4; ++m) { const int row = row0 + ai * HALF + m * 16; const float rs = __builtin_amdgcn_rsqf(sq[ai * 4 + m] * (1.f / DM) + EPS) * sc; bf16_t* rowp = O + (size_t)row * ldc + col0;
#pragma unroll
                for (int bj = 0; bj < 2; ++bj) { const f32x4 v0 = acc[ai][bj][m][0] * rs + bv[bj][0], v1 = acc[ai][bj][m][1] * rs + bv[bj][1];
                    u32x4 w; w.x = cvt_pk_bf16(v0[0], v0[1]); w.y = cvt_pk_bf16(v0[2], v0[3]); w.z = cvt_pk_bf16(v1[0], v1[1]); w.w = cvt_pk_bf16(v1[2], v1[3]);
                    STG(u32x4, rowp + bj * HALF) = w; } }
    }
};
template <bool NEXT> struct EpiRes {
    static constexpr bool PERM = false;
    const float* base_p; const float* base_s;
    float* out; const float* gate;
    bf16_t* xres;
    bf16_t* xg; const float* gain; const float* scale; float* ssq;
    __device__ __forceinline__ void operator()(const f32x4 (&acc)[2][2][4][2], const Unit& u, int wr, int wc, int fr, int fq) const {
        const int row0 = u.pm * BM + wr * 64 + fr, col0 = u.pn * BM + wc * 32 + 4 * fq;
        const float* base = (u.pm * BM < TOKP) ? base_p : base_s;
        const int b = batch_of(u.pm * BM);
        const float* gp = gate + (size_t)b * (6 * DM) + col0;
        f32x4 gv[2][2], gg[2][2], gs[2][2];
#pragma unroll
        for (int bj = 0; bj < 2; ++bj)
#pragma unroll
            for (int n = 0; n < 2; ++n) { gv[bj][n] = LDG(f32x4, gp + bj * HALF + n * 16);
                if (NEXT) { gg[bj][n] = LDG(f32x4, gain + col0 + bj * HALF + n * 16); gs[bj][n] = LDG(f32x4, scale + (size_t)b * (6 * DM) + col0 + bj * HALF + n * 16); } }
        f32x4 bs0[2][2][2];
#pragma unroll
        for (int mm = 0; mm < 2; ++mm)
#pragma unroll
            for (int bj = 0; bj < 2; ++bj)
#pragma unroll
                for (int n = 0; n < 2; ++n) { const size_t o_ = (size_t)(row0 + mm * 16) * DM + col0 + bj * HALF + n * 16;
                    if (RES_BF16) { const u32x2 r = LDG(u32x2, xres + o_); bs0[mm][bj][n] = (f32x4){bf_lo(r.x), bf_hi(r.x), bf_lo(r.y), bf_hi(r.y)}; }
                    else bs0[mm][bj][n] = LDG(f32x4, base + o_); }
        asm volatile("" ::: "memory");
        if (NEXT) {
#pragma unroll
            for (int bj = 0; bj < 2; ++bj)
#pragma unroll
                for (int n = 0; n < 2; ++n) gg[bj][n] = gg[bj][n] * (gs[bj][n] + 1.0f); }
#pragma unroll
        for (int ai = 0; ai < 2; ++ai)
#pragma unroll
        for (int mp = 0; mp < 2; ++mp) {
            f32x4 bs[2][2][2];
#pragma unroll
            for (int mm = 0; mm < 2; ++mm)
#pragma unroll
                for (int bj = 0; bj < 2; ++bj)
#pragma unroll
                    for (int n = 0; n < 2; ++n) { const size_t o_ = (size_t)(row0 + ai * HALF + (2 * mp + mm) * 16) * DM + col0 + bj * HALF + n * 16;
                        if (ai == 0 && mp == 0) bs[mm][bj][n] = bs0[mm][bj][n];
                        else if (RES_BF16) { const u32x2 r = LDG(u32x2, xres + o_); bs[mm][bj][n] = (f32x4){bf_lo(r.x), bf_hi(r.x), bf_lo(r.y), bf_hi(r.y)}; }
                        else bs[mm][bj][n] = LDG(f32x4, base + o_); }
            asm volatile("" ::: "memory");
#pragma unroll
            for (int mm = 0; mm < 2; ++mm) { const int m = 2 * mp + mm; const int row = row0 + ai * HALF + m * 16; const size_t off = (size_t)row * DM + col0; float ss = 0.f;
#pragma unroll
                for (int bj = 0; bj < 2; ++bj)
#pragma unroll
                    for (int n = 0; n < 2; ++n) { const f32x4 xn = bs[mm][bj][n] + gv[bj][n] * acc[ai][bj][m][n];
                        if (RES_BF16) { u32x2 w_; w_.x = cvt_pk_bf16(xn[0], xn[1]); w_.y = cvt_pk_bf16(xn[2], xn[3]); STG(u32x2, xres + off + bj * HALF + n * 16) = w_; }
                        else STG(f32x4, out + off + bj * HALF + n * 16) = xn;
                        if (NEXT) { ss += (xn[0] * xn[0] + xn[1] * xn[1]) + (xn[2] * xn[2] + xn[3] * xn[3]); const f32x4 y = xn * gg[bj][n];
                            u32x2 w; w.x = cvt_pk_bf16(y[0], y[1]); w.y = cvt_pk_bf16(y[2], y[3]); STG(u32x2, xg + off + bj * HALF + n * 16) = w; } }
                if (NEXT) { ss += swz_xor<16>(ss); auto rr = __builtin_amdgcn_permlane32_swap(__float_as_uint(ss), __float_as_uint(ss), false, false); ss = __uint_as_float(rr[0]) + __uint_as_float(rr[1]);
                    if (fq == 0) atomicAdd(ssq + row, ss); } }
            asm volatile("" ::: "memory");
        }
    }
};
struct EpiNull {
    static constexpr bool PERM = true;
    __device__ __forceinline__ void operator()(f32x4 (&acc)[2][2][4][2], const Unit&, int, int, int, int) const {
#pragma unroll
        for (int ai = 0; ai < 2; ++ai)
#pragma unroll
            for (int m = 0; m < 4; ++m) asm volatile("" :: "v"(acc[ai][0][m][0]), "v"(acc[ai][0][m][1]), "v"(acc[ai][1][m][0]), "v"(acc[ai][1][m][1]));
    }
};
struct EpiGLU {
    static constexpr bool PERM = true;
    bf16_t* G; const float* cw; const float* cb; const float* ssq; const float* bias;
    __device__ __forceinline__ void operator()(f32x4 (&acc)[2][2][4][2], const Unit& u, int wr, int wc, int fr, int fq) const {
        const int lane = (fq << 4) | fr;
        const int f0 = 128 * u.pn + 32 * wc + 8 * fq;
        const int tok0 = 252 * u.pm + 126 * wr - 1;
        {
            const int tq = tok0 + 8 * fr; const int tA = tq < 0 ? 0 : (tq > TOK - 1 ? TOK - 1 : tq), tB = (tq + 7) > TOK - 1 ? TOK - 1 : (tq + 7);
            const int bA = batch_of(tA), bB = batch_of(tB); const bool same = __all(bA == bB);
            const float* bp0 = bias + 256 * u.pn + 32 * wc + 8 * fq;
            f32x4 bvA[2][2]; float sq[8];
#pragma unroll
            for (int am = 0; am < 8; ++am) { int tok = tq + am; tok = tok < 0 ? 0 : (tok > TOK - 1 ? TOK - 1 : tok); sq[am] = LDG(float, ssq + tok); }
#pragma unroll
            for (int bj = 0; bj < 2; ++bj)
#pragma unroll
                for (int n = 0; n < 2; ++n) bvA[bj][n] = LDG(f32x4, bp0 + (size_t)bA * (2 * DFF) + bj * HALF + 4 * n);
#pragma unroll
            for (int am = 0; am < 8; ++am) { const int ai = am >> 2, m = am & 3;
                const float rs = __builtin_amdgcn_rsqf(sq[am] * (1.f / DM) + EPS);
#pragma unroll
                for (int bj = 0; bj < 2; ++bj)
#pragma unroll
                    for (int n = 0; n < 2; ++n) acc[ai][bj][m][n] = acc[ai][bj][m][n] * rs + bvA[bj][n];
                asm volatile("" : "+v"(acc[ai][0][m][0]), "+v"(acc[ai][0][m][1]), "+v"(acc[ai][1][m][0]), "+v"(acc[ai][1][m][1])); }
            if (!same) {
                asm volatile("" ::: "memory");
                f32x4 dv[2][2];
#pragma unroll
                for (int bj = 0; bj < 2; ++bj)
#pragma unroll
                    for (int n = 0; n < 2; ++n) dv[bj][n] = LDG(f32x4, bp0 + (size_t)bB * (2 * DFF) + bj * HALF + 4 * n) - bvA[bj][n];
#pragma unroll
                for (int am = 0; am < 8; ++am) { const int ai = am >> 2, m = am & 3; int tok = tq + am; tok = tok < 0 ? 0 : (tok > TOK - 1 ? TOK - 1 : tok);
                    const float mB = (batch_of(tok) == bA) ? 0.f : 1.f;
#pragma unroll
                    for (int bj = 0; bj < 2; ++bj)
#pragma unroll
                        for (int n = 0; n < 2; ++n) acc[ai][bj][m][n] += dv[bj][n] * mB; } } }
        f32x4 w0[2], w1[2], w2[2], cbv[2];
#pragma unroll
        for (int n = 0; n < 2; ++n) { w0[n] = LDG(f32x4, cw + f0 + 4 * n); w1[n] = LDG(f32x4, cw + DFF + f0 + 4 * n); w2[n] = LDG(f32x4, cw + 2 * DFF + f0 + 4 * n); cbv[n] = LDG(f32x4, cb + f0 + 4 * n); }
        const int srcR = ((lane & 48) | ((fr + 15) & 15)) << 2, srcL = ((lane & 48) | ((fr + 1) & 15)) << 2;
        f32x4 pvx[2], nvx[2];
#pragma unroll
        for (int n = 0; n < 2; ++n)
#pragma unroll
            for (int e = 0; e < 4; ++e) { pvx[n][e] = bperm(acc[1][0][3][n][e], srcR); nvx[n][e] = bperm(acc[0][0][0][n][e], srcL); }
        const int tokl = tok0 + 8 * fr;
        const int S = seq_len_of(tokl < 0 ? 0 : tokl);
#pragma unroll
        for (int am = 0; am < 8; ++am) {
            const int ai = am >> 2, m = am & 3;
            const int j = 8 * fr + am, tok = tokl + am, tpos = tok & (S - 1);
            const bool first = (tpos == 0), lastt = (tpos == S - 1); const bool edge = __any(first || lastt);
            const bool ok = (j >= 1) && (j <= 126) && (tok < TOK);
            u32x4 w;
#pragma unroll
            for (int n = 0; n < 2; ++n) {
                f32x4 pv = (am == 0) ? pvx[n] : acc[(am - 1 < 0 ? 0 : am - 1) >> 2][0][(am - 1 < 0 ? 0 : am - 1) & 3][n];
                f32x4 nv = (am == 7) ? nvx[n] : acc[(am + 1 > 7 ? 7 : am + 1) >> 2][0][(am + 1 > 7 ? 7 : am + 1) & 3][n];
                f32x4 v = cbv[n] + w0[n] * pv + w1[n] * acc[ai][0][m][n] + w2[n] * nv;
                if (edge) {
                    asm volatile("" ::: "memory");
                    const f32x4 z = {0.f, 0.f, 0.f, 0.f}; const f32x4 pz = first ? z : pv, nz = lastt ? z : nv;
                    v = cbv[n] + w0[n] * pz + w1[n] * acc[ai][0][m][n] + w2[n] * nz; }
                const f32x2 g0 = gelu_pk((f32x2){v[0], v[1]}), g1 = gelu_pk((f32x2){v[2], v[3]});
                const f32x4 bb = acc[ai][1][m][n];
                const unsigned lo = cvt_pk_bf16(g0.x * bb[0], g0.y * bb[1]), hi = cvt_pk_bf16(g1.x * bb[2], g1.y * bb[3]);
                if (n == 0) { w.x = lo; w.y = hi; } else { w.z = lo; w.w = hi; }
            }
            if (ok) STG(u32x4, G + (size_t)tok * DFF + f0) = w;
        }
    }
};
}

struct Args { const float* in[26]; float* out; unsigned char* ws; int ph_lo, ph_hi; };
struct Frame {
    LAS unsigned char* lds; int tid, lane, wave, vcu, G, gw, NGW;
    unsigned long long kargs; float* out; unsigned char* ws;
    bf16_t* hbuf; bf16_t* hbuf2; bf16_t* big; float* mod; float* lse; float* ssq; float* bias; bf16_t* xb;
};
__device__ __forceinline__ Frame fresh(const Frame& F0) { Frame F = F0;
    asm volatile("" : "+v"(F.tid), "+v"(F.lane), "+s"(F.wave), "+s"(F.vcu), "+s"(F.G), "+s"(F.gw), "+s"(F.NGW), "+s"(F.kargs));
    asm volatile("" : "+s"(F.out), "+s"(F.ws), "+s"(F.hbuf), "+s"(F.big), "+s"(F.mod), "+s"(F.lse)); asm volatile("" : "+s"(F.hbuf2), "+s"(F.ssq), "+s"(F.bias), "+s"(F.xb)); return F; }
__device__ __forceinline__ const float* argp(const Frame& F, int idx) { unsigned long long p = F.kargs; asm volatile("" : "+s"(p)); return ((const float* const __attribute__((address_space(4)))*)p)[idx]; }
__device__ __forceinline__ bf16_t* wt_ptr(const Frame& F, int layer, size_t off) { return (bf16_t*)(F.ws + WS_WT + (size_t)layer * LWT + off); }

__device__ __forceinline__ void transpose_item(const float* W, int K, int N, bf16_t* WT, int dest_row0, int k0, int n0, LAS float* scr, int lane) {
    float wv[32];
#pragma unroll
    for (int i = 0; i < 32; ++i) { const int kk = 2 * i + (lane >> 5); wv[i] = LDG(float, W + (size_t)(k0 + kk) * N + n0 + (lane & 31)); }
#pragma unroll
    for (int i = 0; i < 32; ++i) { const int kk = 2 * i + (lane >> 5); scr[kk * 33 + (lane & 31)] = wv[i]; }
    asm volatile("s_waitcnt lgkmcnt(0)" ::: "memory");
    const int c = lane & 7;
#pragma unroll
    for (int j = 0; j < 4; ++j) { const int n = (lane >> 3) + 8 * j; const LAS float* s = scr + (8 * c) * 33 + n;
        u32x4 o; o.x = cvt_pk_bf16(s[0 * 33], s[1 * 33]); o.y = cvt_pk_bf16(s[2 * 33], s[3 * 33]); o.z = cvt_pk_bf16(s[4 * 33], s[5 * 33]); o.w = cvt_pk_bf16(s[6 * 33], s[7 * 33]);
        STG(u32x4, WT + (size_t)(dest_row0 + n) * K + k0 + 8 * c) = o; }
    asm volatile("s_waitcnt lgkmcnt(0)" ::: "memory");
}
__device__ __forceinline__ void phase_weights(const Frame& F0, int lmask, int cu0, int ncu, int pm) {
    const Frame F = fresh(F0);
    LAS float* scr = (LAS float*)(F.lds + F.wave * 16384);
    const int gw_ = ncu ? ((int)blockIdx.x - cu0) * NWAVES + F.wave : F.gw, ngw_ = ncu ? ncu * NWAVES : F.NGW;
    for (int layer = 0; layer < 4; ++layer) {
        if (!((lmask >> layer) & 1)) continue;
        const int NQ = (layer == 2) ? 4096 : 3072;
        const float* wqkv = argp(F, layer == 0 ? 8 : layer == 1 ? 12 : layer == 2 ? 15 : 19);
        const float* wo = argp(F, layer == 0 ? 11 : layer == 1 ? 14 : layer == 2 ? 18 : 20);
        const float* wup = argp(F, 21) + (size_t)layer * DM * 2 * DFF;
        const float* wdn = argp(F, 24) + (size_t)layer * DFF * DM;
        const int I_Q = 32 * (NQ / 32), I_O = 32 * (DM / 32), I_U = 32 * (2 * DFF / 32), I_D = (DFF / 64) * (DM / 32);
        const int NIT = I_Q + I_O + I_U + I_D;
        const int it_lo = (pm & 1) ? 0 : (pm & 2) ? I_Q : (pm & 4) ? I_Q + I_O : I_Q + I_O + I_U, it_hi = (pm & 8) ? NIT : (pm & 4) ? I_Q + I_O + I_U : (pm & 2) ? I_Q + I_O : I_Q;
        for (int it = it_lo + gw_; it < it_hi; it += ngw_) {
            int r = it;
            if (r < I_Q) { const int nblk = NQ / 32, kb = r / nblk, nb = r % nblk; transpose_item(wqkv, DM, NQ, wt_ptr(F, layer, WT_QKV), 32 * nb, 64 * kb, 32 * nb, scr, F.lane); continue; } r -= I_Q;
            if (r < I_O) { const int nblk = DM / 32, kb = r / nblk, nb = r % nblk; transpose_item(wo, DM, DM, wt_ptr(F, layer, WT_WO), 32 * nb, 64 * kb, 32 * nb, scr, F.lane); continue; } r -= I_O;
            if (r < I_U) { const int nblk = 2 * DFF / 32, kb = r / nblk, nb = r % nblk; const int n0 = 32 * nb; const int half = n0 >= DFF ? 1 : 0, nn = n0 - half * DFF;
                const int drow = (nn >> 7) * 256 + half * 128 + (nn & 127);
                transpose_item(wup, DM, 2 * DFF, wt_ptr(F, layer, WT_UP), drow, 64 * kb, n0, scr, F.lane); continue; } r -= I_U;
            { const int nblk = DM / 32, kb = r / nblk, nb = r % nblk; transpose_item(wdn, DFF, DM, wt_ptr(F, layer, WT_DOWN), 32 * nb, 64 * kb, 32 * nb, scr, F.lane); }
        }
    }
}
__device__ __forceinline__ void phase_mod(const Frame& F0) {
    const Frame F = fresh(F0);
    LAS float* sl = (LAS float*)F.lds;
    LAS float* red = (LAS float*)(F.lds + 98304);
    { const float* cp = argp(F, 2); const float* cs = argp(F, 3); float cv[48];
#pragma unroll
      for (int r = 0; r < 48; ++r) { const int i = F.tid + r * NTHREADS, bb = i >> 11, d = i & 2047; cv[r] = bb < 4 ? LDG(float, cp + bb * DM + d) : LDG(float, cs + (bb - 4) * DM + d); }
#pragma unroll
      for (int r = 0; r < 48; ++r) { const int i = F.tid + r * NTHREADS, bb = i >> 11, d = i & 2047; const float c = cv[r]; sl[d * NB + bb] = c / (1.f + __expf(-c)); } }
    __syncthreads();
    const int col = F.tid & 63, kg = F.tid >> 6;
    for (int unit = F.vcu; unit < 4 * 192; unit += F.G) {
        const int l = unit / 192, n0 = (unit % 192) * 64;
        const float* w = argp(F, 6) + (size_t)l * DM * (6 * DM) + n0 + col;
        float acc[NB];
#pragma unroll
        for (int b = 0; b < NB; ++b) acc[b] = 0.f;
        for (int d0 = kg * 256; d0 < kg * 256 + 256; d0 += 32) {
            float wvv[32];
#pragma unroll
            for (int i = 0; i < 32; ++i) wvv[i] = LDG(float, w + (size_t)(d0 + i) * (6 * DM));
#pragma unroll
            for (int i = 0; i < 32; ++i) { const int d = d0 + i; const float wv = wvv[i];
                const f32x4 s0 = *(const LAS f32x4*)(sl + d * NB), s1 = *(const LAS f32x4*)(sl + d * NB + 4), s2 = *(const LAS f32x4*)(sl + d * NB + 8);
                acc[0] += wv * s0[0]; acc[1] += wv * s0[1]; acc[2] += wv * s0[2]; acc[3] += wv * s0[3];
                acc[4] += wv * s1[0]; acc[5] += wv * s1[1]; acc[6] += wv * s1[2]; acc[7] += wv * s1[3];
                acc[8] += wv * s2[0]; acc[9] += wv * s2[1]; acc[10] += wv * s2[2]; acc[11] += wv * s2[3]; } }
#pragma unroll
        for (int b = 0; b < NB; ++b) red[(kg * NB + b) * 64 + col] = acc[b];
        __syncthreads();
        for (int o = F.tid; o < NB * 64; o += NTHREADS) { const int b = o >> 6, c2 = o & 63; float s = 0.f;
#pragma unroll
            for (int k = 0; k < 8; ++k) s += red[(k * NB + b) * 64 + c2];
            F.mod[((size_t)l * NB + b) * (6 * DM) + n0 + c2] = s + argp(F, 7)[(size_t)l * 6 * DM + n0 + c2]; }
        __syncthreads();
    }
}
__device__ __forceinline__ void phase_norm0(const Frame& F0, const float* xp, const float* xs, const float* gain, const float* modl, int sc_chunk, float* ssq) {
    const Frame F = fresh(F0);
    for (int row = F.gw; row < TOK; row += F.NGW) {
        const float* xr = (row < TOKP ? xp : xs) + (size_t)row * DM;
        const float* mb = modl + (size_t)batch_of(row) * (6 * DM);
        float ss = 0.f; bf16_t* orow = F.hbuf + (size_t)row * DM;
        f32x4 v[8], gn[8], sc[8];
#pragma unroll
        for (int j = 0; j < 8; ++j) { const int c = 4 * (F.lane + 64 * j); v[j] = LDG(f32x4, xr + c); gn[j] = LDG(f32x4, gain + c); sc[j] = LDG(f32x4, mb + sc_chunk * DM + c); }
        asm volatile("" ::: "memory");
#pragma unroll
        for (int j = 0; j < 8; ++j) { const int c = 4 * (F.lane + 64 * j); ss += (v[j][0] * v[j][0] + v[j][1] * v[j][1]) + (v[j][2] * v[j][2] + v[j][3] * v[j][3]);
            const f32x4 y = v[j] * gn[j] * (sc[j] + 1.0f);
            u32x2 w; w.x = cvt_pk_bf16(y[0], y[1]); w.y = cvt_pk_bf16(y[2], y[3]); STG(u32x2, orow + c) = w;
            if (RES_BF16) { u32x2 wx; wx.x = cvt_pk_bf16(v[j][0], v[j][1]); wx.y = cvt_pk_bf16(v[j][2], v[j][3]); STG(u32x2, F.xb + (size_t)row * DM + c) = wx; } }
        ss = wave_sum(ss);
        if (F.lane == 0) STG(float, ssq + row) = ss;
    }
}
__device__ __forceinline__ void phase_bias(const Frame& F0, int lmask, int cu0, int ncu, int pmask) {
    const Frame F = fresh(F0);
    LAS bf16_t* sh = (LAS bf16_t*)F.lds;
    const int fr = F.lane & 15, fq = F.lane >> 4;
    const int gw_ = ncu ? ((int)blockIdx.x - cu0) * NWAVES + F.wave : F.gw, ngw_ = ncu ? ncu * NWAVES : F.NGW;
    for (int l = 0; l < 4; ++l) {
        if (!((lmask >> l) & 1)) continue;
        const int NQ = (l == 2) ? 4096 : 3072;
#pragma unroll 1
        for (int part = 0; part < 2; ++part) {
            if (!((pmask >> part) & 1)) continue;
            __syncthreads();
            {
                f32x2 mv[2 * NB];
#pragma unroll
                for (int r = 0; r < 2 * NB; ++r) { const int i = F.tid + r * NTHREADS, bb = i >> 10, d = 2 * (i & 1023);
                    mv[r] = LDG(f32x2, F.mod + ((size_t)l * NB + bb) * (6 * DM) + (part ? 3 : 0) * DM + d); }
#pragma unroll
                for (int r = 0; r < 2 * NB; ++r) ((LAS unsigned*)sh)[F.tid + r * NTHREADS] = cvt_pk_bf16(mv[r][0], mv[r][1]);
#pragma unroll
                for (int r = 2 * NB; r < 32; ++r) ((LAS unsigned*)sh)[F.tid + r * NTHREADS] = 0u; }
            __syncthreads();
            const int N = part ? 2 * DFF : NQ; const bf16_t* Wt = wt_ptr(F, l, part ? WT_UP : WT_QKV); float* bo = F.bias + (size_t)l * BIAS_L + (part ? 12 * 4096 : 0);
            for (int n0 = 16 * gw_; n0 < N; n0 += 16 * ngw_) {
                f32x4 acc = {0.f, 0.f, 0.f, 0.f};
                const bf16_t* wp = Wt + (size_t)(n0 + fr) * DM + 8 * fq; const LAS bf16_t* sp = sh + fr * DM + 8 * fq;
#pragma unroll 1
                for (int k0 = 0; k0 < DM; k0 += 256) {
                    bf16x8 wv[8];
#pragma unroll
                    for (int j = 0; j < 8; ++j) wv[j] = LDG(bf16x8, wp + k0 + 32 * j);
#pragma unroll
                    for (int j = 0; j < 8; ++j) acc = __builtin_amdgcn_mfma_f32_16x16x32_bf16(wv[j], *(const LAS bf16x8*)(sp + k0 + 32 * j), acc, 0, 0, 0);
                }
                if (fr < NB) STG(f32x4, bo + (size_t)fr * N + n0 + 4 * fq) = acc;
            }
        }
    }
}
__device__ __forceinline__ void phase_final_norm(const Frame& F0, const float* gain) {
    const Frame F = fresh(F0);
    for (int row = F.gw; row < TOK; row += F.NGW) {
        float* xr = F.out + (size_t)row * DM;
        f32x4 v[8]; float ss = 0.f;
#pragma unroll
        for (int j = 0; j < 8; ++j) { const int c = 4 * (F.lane + 64 * j);
            if (RES_BF16) { const u32x2 r = LDG(u32x2, F.xb + (size_t)row * DM + c); v[j] = (f32x4){bf_lo(r.x), bf_hi(r.x), bf_lo(r.y), bf_hi(r.y)}; } else v[j] = LDG(f32x4, xr + c);
            ss += (v[j][0] * v[j][0] + v[j][1] * v[j][1]) + (v[j][2] * v[j][2] + v[j][3] * v[j][3]); }
        const float rstd = 1.0f / sqrtf(wave_sum(ss) * (1.f / DM) + EPS);
#pragma unroll
        for (int j = 0; j < 8; ++j) { const int c = 4 * (F.lane + 64 * j); const f32x4 g = LDG(f32x4, gain + c); STG(f32x4, xr + c) = (v[j] * rstd) * g; }
    }
}
__device__ __forceinline__ void phase_ropetab(const Frame& F0) {
    const Frame F = fresh(F0);
    float* tab = (float*)(F.ws + WS_ROPE);
    for (int i = F.gw * 64 + F.lane; i < 64 * 32; i += F.NGW * 64) { const int f = i & 31; const float invf = exp2f(-(float)f * (13.287712379549449f / 32.f));
        float sn, cs; sincosf((float)(i >> 5) * invf, &sn, &cs); STG(f32x2, tab + 2 * i) = (f32x2){cs, sn}; }
}
template <bool QFOLD>
__device__ __forceinline__ void phase_qknorm_rope(const Frame& F0, const float* qn, const float* kn) {
    const Frame F = fresh(F0);
    const int k16 = F.lane & 15, grp = F.lane >> 4;
    for (int T = F.gw; T < TOK; T += F.NGW) {
        const int S = seq_len_of(T), t = T & (S - 1);
        const float posv = (k16 & 8) ? (float)(t & 63) : (float)(t >> 6);
        float cs[8], sn[8];
#pragma unroll
        for (int e = 0; e < 8; ++e) { const int f = 8 * (k16 & 3) + e; const float invf = exp2f(-(float)f * (13.287712379549449f / 32.f)); sincosf(posv * invf, &sn[e], &cs[e]); }
        const float sgn = (k16 & 4) ? 1.f : -1.f;
        bf16_t* rowp = F.big + (size_t)T * 3072;
        u32x4 raws[5];
#pragma unroll
        for (int it = QFOLD ? 4 : 0; it < 5; ++it) raws[it] = LDG(u32x4, rowp + (it * 4 + grp) * 128 + 8 * k16);
        asm volatile("" ::: "memory");
#pragma unroll
        for (int it = QFOLD ? 4 : 0; it < 5; ++it) {
            const int head = it * 4 + grp;
            bf16_t* p = rowp + head * 128 + 8 * k16;
            const u32x4 raw = raws[it];
            float x[8] = {bf_lo(raw.x), bf_hi(raw.x), bf_lo(raw.y), bf_hi(raw.y), bf_lo(raw.z), bf_hi(raw.z), bf_lo(raw.w), bf_hi(raw.w)};
            float ss = 0.f;
#pragma unroll
            for (int e = 0; e < 8; ++e) ss += x[e] * x[e];
            ss += swz_xor<1>(ss); ss += swz_xor<2>(ss); ss += swz_xor<4>(ss); ss += swz_xor<8>(ss);
            const float rstd = 1.0f / sqrtf(ss * (1.f / 128.f) + EPS);
            const float* gsrc = (head < 16 ? qn : kn) + 8 * k16;
            const float osc = head < 16 ? QSCALE : 1.f;
            float y[8], o[8];
#pragma unroll
            for (int e = 0; e < 8; ++e) y[e] = x[e] * rstd * gsrc[e];
#pragma unroll
            for (int e = 0; e < 8; ++e) { const float partner = swz_xor<4>(y[e]); o[e] = (y[e] * cs[e] + sgn * partner * sn[e]) * osc; }
            u32x4 w; w.x = cvt_pk_bf16(o[0], o[1]); w.y = cvt_pk_bf16(o[2], o[3]); w.z = cvt_pk_bf16(o[4], o[5]); w.w = cvt_pk_bf16(o[6], o[7]);
            STG(u32x4, p) = w;
        }
    }
}

__device__ __forceinline__ void q_to_lds(LAS float* qs, const bf16_t* q, int lane) { const unsigned w = *(const unsigned*)(q + 2 * lane); qs[2 * lane] = bf_lo(w); qs[2 * lane + 1] = bf_hi(w); }
__device__ __forceinline__ float qk_dot(const LAS float* qs, const bf16_t* krow) {
    float s = 0.f;
#pragma unroll
    for (int i = 0; i < 16; ++i) { const u32x4 kv = *(const u32x4*)(krow + 8 * i); const f32x4 qa = *(const LAS f32x4*)(qs + 8 * i), qb = *(const LAS f32x4*)(qs + 8 * i + 4);
        s += qa[0] * bf_lo(kv.x) + qa[1] * bf_hi(kv.x) + qa[2] * bf_lo(kv.y) + qa[3] * bf_hi(kv.y) + qb[0] * bf_lo(kv.z) + qb[1] * bf_hi(kv.z) + qb[2] * bf_lo(kv.w) + qb[3] * bf_hi(kv.w); }
    return s;
}
template <int NV> struct OSt { float m, l; float o[NV / 64]; };
template <int NV> __device__ __forceinline__ void attn_chunk(OSt<NV>& st, float s, int voff, const bf16_t* base, int lane) {
    const float cm = wave_max(s);
    if (cm == -INFINITY) return;
    const float mn = fmaxf(st.m, cm), alpha = __builtin_amdgcn_exp2f(st.m - mn), p = __builtin_amdgcn_exp2f(s - mn);
    st.l = st.l * alpha + wave_sum(p); st.m = mn;
#pragma unroll
    for (int k = 0; k < NV / 64; ++k) st.o[k] *= alpha;
    for (int jj = 0; jj < 64; ++jj) {
        const float pj = __uint_as_float(__builtin_amdgcn_readlane(__float_as_uint(p), jj));
        if (pj != 0.f) { const int off = __builtin_amdgcn_readlane(voff, jj);
            if (NV == 128) { const unsigned w = *(const unsigned*)(base + off + 2 * lane); st.o[0] += pj * bf_lo(w); st.o[1] += pj * bf_hi(w); }
            else { const u32x2 w = *(const u32x2*)(base + off + 4 * lane); st.o[0] += pj * bf_lo(w.x); st.o[1] += pj * bf_hi(w.x); st.o[2] += pj * bf_lo(w.y); st.o[3] += pj * bf_hi(w.y); } }
    }
}
template <int MIX> __device__ __forceinline__ void phase_attn_naive(const Frame& F0) {
    const Frame F = fresh(F0);
    LAS float* qs = (LAS float*)(F.lds + F.wave * 1024);
    const int NH = (MIX == 2) ? 8 : 16, W = (MIX == 2) ? 4096 : 3072;
    const bf16_t* qkv = F.big;
    for (int job = F.gw; job < TOK * NH; job += F.NGW) {
        const int T = job / NH, h = job % NH, S = seq_len_of(T), sb = T & ~(S - 1), t = T - sb;
        if (MIX != 2) {
            const int kvh = h >> 2, kcol = 2048 + kvh * 128, vcol = 2560 + kvh * 128;
            q_to_lds(qs, qkv + (size_t)T * W + h * 128, F.lane);
            asm volatile("s_waitcnt lgkmcnt(0)" ::: "memory");
            OSt<128> st; st.m = -1e30f; st.l = 0.f; st.o[0] = 0.f; st.o[1] = 0.f;
            const float slope2 = exp2f(-0.5f * (float)(h + 1)) * LOG2E;
            if (MIX == 0) {
                for (int c = 0; c < S / 64; ++c) { const int pos = 64 * c + F.lane; const int ro = (sb + pos) * W;
                    const float s = qk_dot(qs, qkv + ro + kcol); attn_chunk<128>(st, s, ro + vcol, qkv, F.lane); }
            } else if (MIX == 1) {
                st.m = argp(F, 13)[h] * LOG2E; st.l = 1.f;
                for (int c = 0; c < 5; ++c) { const int pos = t - 128 + 64 * c + F.lane; const int d = pos - t; const bool valid = (d >= -128) && (d <= 128) && (pos >= 0) && (pos < S);
                    const int pc = pos < 0 ? 0 : (pos > S - 1 ? S - 1 : pos); const int ro = (sb + pc) * W;
                    float s = qk_dot(qs, qkv + ro + kcol) - slope2 * fabsf((float)d); s = valid ? s : -INFINITY; attn_chunk<128>(st, s, ro + vcol, qkv, F.lane); }
            } else {
#pragma unroll
                for (int br = 0; br < 3; ++br) { const int dil = br == 0 ? 1 : br == 1 ? 4 : 16;
                    for (int c = 0; c < 3; ++c) { const int j = -64 + 64 * c + F.lane; const int pos = t + dil * j; const bool valid = (j <= 64) && (pos >= 0) && (pos < S);
                        const int pc = pos < 0 ? 0 : (pos > S - 1 ? S - 1 : pos); const int ro = (sb + pc) * W;
                        float s = qk_dot(qs, qkv + ro + kcol) - slope2 * (float)dil * fabsf((float)j); s = valid ? s : -INFINITY; attn_chunk<128>(st, s, ro + vcol, qkv, F.lane); } }
            }
            const float rl = 1.0f / st.l;
            *(unsigned*)(F.hbuf2 + (size_t)T * DM + h * 128 + 2 * F.lane) = cvt_pk_bf16(st.o[0] * rl, st.o[1] * rl);
        } else {
            const int kvh = h >> 1; const float slope2 = exp2f(-(float)(h + 1)) * LOG2E;
            const float* lp = argp(F, 16);
            const float d1 = wave_sum(lp[F.lane] * lp[128 + F.lane] + lp[64 + F.lane] * lp[192 + F.lane]);
            const float d2 = wave_sum(lp[256 + F.lane] * lp[384 + F.lane] + lp[320 + F.lane] * lp[448 + F.lane]);
            const float lam = expf(d1) - expf(d2) + LAM_INIT2;
            float om[2][4];
#pragma unroll
            for (int mp = 0; mp < 2; ++mp) {
                const int kcol = 2048 + kvh * 256 + mp * 128, vcol = 3072 + kvh * 256;
                q_to_lds(qs, qkv + (size_t)T * W + h * 256 + mp * 128, F.lane);
                asm volatile("s_waitcnt lgkmcnt(0)" ::: "memory");
                OSt<256> st; st.m = -1e30f; st.l = 0.f; st.o[0] = st.o[1] = st.o[2] = st.o[3] = 0.f;
                for (int c = 0; c < S / 64; ++c) { const int pos = 64 * c + F.lane; const int ro = (sb + pos) * W;
                    const float s = qk_dot(qs, qkv + ro + kcol) - slope2 * fabsf((float)(pos - t)); attn_chunk<256>(st, s, ro + vcol, qkv, F.lane); }
                const float rl = 1.0f / st.l;
#pragma unroll
                for (int k = 0; k < 4; ++k) om[mp][k] = st.o[k] * rl;
                asm volatile("s_waitcnt lgkmcnt(0)" ::: "memory");
            }
            float dd[4], ss = 0.f;
#pragma unroll
            for (int k = 0; k < 4; ++k) { dd[k] = om[0][k] - lam * om[1][k]; ss += dd[k] * dd[k]; }
            const float rstd = 1.0f / sqrtf(wave_sum(ss) * (1.f / 256.f) + EPS);
            const f32x4 sg = *(const f32x4*)(argp(F, 17) + 4 * F.lane);
            u32x2 w; w.x = cvt_pk_bf16(dd[0] * rstd * sg[0] * (1.f - LAM_INIT2), dd[1] * rstd * sg[1] * (1.f - LAM_INIT2));
            w.y = cvt_pk_bf16(dd[2] * rstd * sg[2] * (1.f - LAM_INIT2), dd[3] * rstd * sg[3] * (1.f - LAM_INIT2));
            *(u32x2*)(F.hbuf2 + (size_t)T * DM + h * 256 + 4 * F.lane) = w;
        }
    }
}

namespace fa {
using f32x16 = __attribute__((ext_vector_type(16))) float;
using s16x4  = __attribute__((ext_vector_type(4))) short;
constexpr int KVBLK = 64;
constexpr int SHM_V = KVBLK * 128 * 2, SHM_K = SHM_V;
constexpr float THR2 = 8.f * LOG2E;
#define KSWZ(row, colB) ((row) * 256 + ((colB) ^ (((row) & 7) << 4)))
#define SBAR() __builtin_amdgcn_sched_barrier(0)
__device__ __forceinline__ int crow(int r, int hi) { return (r & 3) + 8 * (r >> 2) + 4 * hi; }
__device__ __forceinline__ int v_st(int k, int c) { const int kk = (k & ~0xC) | ((k & 4) << 1) | ((k & 8) >> 1); return ((kk >> 3) * 4 + (c >> 5)) * 512 + ((kk & 7) * 32 + (c & 31)) * 2; }
__device__ __forceinline__ int v_rd_base(int lane) { return ((lane & 3) << 3) | (((lane >> 2) & 3) << 6) | (((lane >> 4) & 1) << 5) | (((lane >> 5) & 1) << 8); }
constexpr int v_rd_off(int d0, int ks, int half) { return d0 * 512 + ks * 4096 + half * 2048; }
template <int OFF> __device__ __forceinline__ s16x4 tr_read(int vb) { s16x4 r; asm volatile("ds_read_b64_tr_b16 %0, %1 offset:%2" : "=&v"(r) : "v"(vb), "i"(OFF) : "memory"); return r; }
template <int D0> __device__ __forceinline__ void pv_one(f32x16& od, int vb, bf16x8 pa0, bf16x8 pa1, bf16x8 pa2, bf16x8 pa3) {
  s16x4 l0 = tr_read<v_rd_off(D0, 0, 0)>(vb), h0 = tr_read<v_rd_off(D0, 0, 1)>(vb), l1 = tr_read<v_rd_off(D0, 1, 0)>(vb), h1 = tr_read<v_rd_off(D0, 1, 1)>(vb);
  s16x4 l2 = tr_read<v_rd_off(D0, 2, 0)>(vb), h2 = tr_read<v_rd_off(D0, 2, 1)>(vb), l3 = tr_read<v_rd_off(D0, 3, 0)>(vb), h3 = tr_read<v_rd_off(D0, 3, 1)>(vb);
  asm volatile("s_waitcnt lgkmcnt(0)" : "+v"(l0), "+v"(h0), "+v"(l1), "+v"(h1), "+v"(l2), "+v"(h2), "+v"(l3), "+v"(h3) :: "memory");
#define PK(L, H) (bf16x8){L[0], L[1], L[2], L[3], H[0], H[1], H[2], H[3]}
  od = __builtin_amdgcn_mfma_f32_32x32x16_bf16(pa0, PK(l0, h0), od, 0, 0, 0);
  od = __builtin_amdgcn_mfma_f32_32x32x16_bf16(pa1, PK(l1, h1), od, 0, 0, 0);
  od = __builtin_amdgcn_mfma_f32_32x32x16_bf16(pa2, PK(l2, h2), od, 0, 0, 0);
  od = __builtin_amdgcn_mfma_f32_32x32x16_bf16(pa3, PK(l3, h3), od, 0, 0, 0);
#undef PK
}
__device__ __forceinline__ bf16x8 kread128(int a) { bf16x8 r; asm volatile("ds_read_b128 %0, %1" : "=&v"(r) : "v"(a) : "memory"); return r; }
template <bool ZERO, class HOOK> __device__ __forceinline__ void qkt_pipe(f32x16& p0, f32x16& p1, const LAS char* Ks, const bf16x8* qr, int r32, int hi, HOOK&& hook) {
  if (ZERO) { p0 = f32x16{}; p1 = f32x16{}; }
#define KRD(d0_, R) kread128((int)(size_t)(Ks + KSWZ((R) + r32, ((d0_) * 16 + hi * 8) * 2)))
  bf16x8 a0 = KRD(0, 0), a1 = KRD(0, 32);
#pragma unroll
  for (int d0 = 0; d0 < 8; ++d0) { bf16x8 c0 = a0, c1 = a1;
    if (d0 + 1 < 8) { c0 = KRD(d0 + 1, 0); c1 = KRD(d0 + 1, 32); asm volatile("s_waitcnt lgkmcnt(2)" : "+v"(a0), "+v"(a1) :: "memory"); }
    else asm volatile("s_waitcnt lgkmcnt(0)" : "+v"(a0), "+v"(a1) :: "memory");
    p0 = __builtin_amdgcn_mfma_f32_32x32x16_bf16(a0, qr[d0], p0, 0, 0, 0);
    p1 = __builtin_amdgcn_mfma_f32_32x32x16_bf16(a1, qr[d0], p1, 0, 0, 0);
    hook(d0);
    a0 = c0; a1 = c1; }
#undef KRD
}
#define VRD8(S, D0, vb) s16x4 S##l0 = tr_read<v_rd_off(D0, 0, 0)>(vb), S##h0 = tr_read<v_rd_off(D0, 0, 1)>(vb), S##l1 = tr_read<v_rd_off(D0, 1, 0)>(vb), S##h1 = tr_read<v_rd_off(D0, 1, 1)>(vb), \
                              S##l2 = tr_read<v_rd_off(D0, 2, 0)>(vb), S##h2 = tr_read<v_rd_off(D0, 2, 1)>(vb), S##l3 = tr_read<v_rd_off(D0, 3, 0)>(vb), S##h3 = tr_read<v_rd_off(D0, 3, 1)>(vb)
#define VWT8(S, N) asm volatile("s_waitcnt lgkmcnt(" #N ")" : "+v"(S##l0), "+v"(S##h0), "+v"(S##l1), "+v"(S##h1), "+v"(S##l2), "+v"(S##h2), "+v"(S##l3), "+v"(S##h3) :: "memory")
#define VPK(L, H) (bf16x8){L[0], L[1], L[2], L[3], H[0], H[1], H[2], H[3]}
#define VMM4(S, od) do { od = __builtin_amdgcn_mfma_f32_32x32x16_bf16(pa0, VPK(S##l0, S##h0), od, 0, 0, 0); od = __builtin_amdgcn_mfma_f32_32x32x16_bf16(pa1, VPK(S##l1, S##h1), od, 0, 0, 0); \
                           od = __builtin_amdgcn_mfma_f32_32x32x16_bf16(pa2, VPK(S##l2, S##h2), od, 0, 0, 0); od = __builtin_amdgcn_mfma_f32_32x32x16_bf16(pa3, VPK(S##l3, S##h3), od, 0, 0, 0); } while (0)
__device__ __forceinline__ void pv_pipe8(f32x16* oA, f32x16* oB, int vbA, int vbB, bf16x8 pa0, bf16x8 pa1, bf16x8 pa2, bf16x8 pa3) {
  VRD8(g0, 0, vbA);
  VRD8(g1, 1, vbA); VWT8(g0, 8); VMM4(g0, oA[0]);
  VRD8(g2, 2, vbA); VWT8(g1, 8); VMM4(g1, oA[1]);
  VRD8(g3, 3, vbA); VWT8(g2, 8); VMM4(g2, oA[2]);
  VRD8(g4, 0, vbB); VWT8(g3, 8); VMM4(g3, oA[3]);
  VRD8(g5, 1, vbB); VWT8(g4, 8); VMM4(g4, oB[0]);
  VRD8(g6, 2, vbB); VWT8(g5, 8); VMM4(g5, oB[1]);
  VRD8(g7, 3, vbB); VWT8(g6, 8); VMM4(g6, oB[2]);
  VWT8(g7, 0); VMM4(g7, oB[3]);
}
#define BI2(R) do { constexpr float c_ = (float)(((R) & 3) + 8 * ((R) >> 2)); p0[R] = fmaf(fabsf(dubn + c_), nslope, negm); p1[R] = fmaf(fabsf(dubn + (c_ + 32.f)), nslope, negm); } while (0)
#define VRD4(S, D0, KS, vb) s16x4 S##l0 = tr_read<v_rd_off(D0, KS, 0)>(vb), S##h0 = tr_read<v_rd_off(D0, KS, 1)>(vb), S##l1 = tr_read<v_rd_off(D0, KS + 1, 0)>(vb), S##h1 = tr_read<v_rd_off(D0, KS + 1, 1)>(vb)
#define VWT4(S, N) asm volatile("s_waitcnt lgkmcnt(" #N ")" : "+v"(S##l0), "+v"(S##h0), "+v"(S##l1), "+v"(S##h1) :: "memory")
#define VMM2(S, od, PA, PB) do { od = __builtin_amdgcn_mfma_f32_32x32x16_bf16(PA, VPK(S##l0, S##h0), od, 0, 0, 0); od = __builtin_amdgcn_mfma_f32_32x32x16_bf16(PB, VPK(S##l1, S##h1), od, 0, 0, 0); } while (0)
__device__ __forceinline__ void pv_pipe8b(f32x16* oA, f32x16* oB, int vbA, int vbB, bf16x8 pa0, bf16x8 pa1, bf16x8 pa2, bf16x8 pa3, f32x16& p0, f32x16& p1, float dubn, float nslope, float negm) {
  VRD4(h0, 0, 0, vbA);
  VRD4(h1, 0, 2, vbA); VWT4(h0, 4); VMM2(h0, oA[0], pa0, pa1); BI2(0);
  VRD4(h2, 1, 0, vbA); VWT4(h1, 4); VMM2(h1, oA[0], pa2, pa3); BI2(1);
  VRD4(h3, 1, 2, vbA); VWT4(h2, 4); VMM2(h2, oA[1], pa0, pa1); BI2(2);
  VRD4(h4, 2, 0, vbA); VWT4(h3, 4); VMM2(h3, oA[1], pa2, pa3); BI2(3);
  VRD4(h5, 2, 2, vbA); VWT4(h4, 4); VMM2(h4, oA[2], pa0, pa1); BI2(4);
  VRD4(h6, 3, 0, vbA); VWT4(h5, 4); VMM2(h5, oA[2], pa2, pa3); BI2(5);
  VRD4(h7, 3, 2, vbA); VWT4(h6, 4); VMM2(h6, oA[3], pa0, pa1); BI2(6);
  VRD4(h8, 0, 0, vbB); VWT4(h7, 4); VMM2(h7, oA[3], pa2, pa3); BI2(7);
  VRD4(h9, 0, 2, vbB); VWT4(h8, 4); VMM2(h8, oB[0], pa0, pa1); BI2(8);
  VRD4(h10, 1, 0, vbB); VWT4(h9, 4); VMM2(h9, oB[0], pa2, pa3); BI2(9);
  VRD4(h11, 1, 2, vbB); VWT4(h10, 4); VMM2(h10, oB[1], pa0, pa1); BI2(10);
  VRD4(h12, 2, 0, vbB); VWT4(h11, 4); VMM2(h11, oB[1], pa2, pa3); BI2(11);
  VRD4(h13, 2, 2, vbB); VWT4(h12, 4); VMM2(h12, oB[2], pa0, pa1); BI2(12);
  VRD4(h14, 3, 0, vbB); VWT4(h13, 4); VMM2(h13, oB[2], pa2, pa3); BI2(13);
  VRD4(h15, 3, 2, vbB); VWT4(h14, 4); VMM2(h14, oB[3], pa0, pa1); BI2(14);
  VWT4(h15, 0); VMM2(h15, oB[3], pa2, pa3); BI2(15);
}
__device__ __forceinline__ void pv_d0_fenced(f32x16* o, int vb, bf16x8 pa0, bf16x8 pa1, bf16x8 pa2, bf16x8 pa3) {
  pv_one<0>(o[0], vb, pa0, pa1, pa2, pa3); SBAR(); pv_one<1>(o[1], vb, pa0, pa1, pa2, pa3); SBAR(); pv_one<2>(o[2], vb, pa0, pa1, pa2, pa3); SBAR(); pv_one<3>(o[3], vb, pa0, pa1, pa2, pa3); SBAR();
}
__device__ __forceinline__ void pv_d0(f32x16* o, int vb, bf16x8 pa0, bf16x8 pa1, bf16x8 pa2, bf16x8 pa3) {
  pv_one<0>(o[0], vb, pa0, pa1, pa2, pa3); pv_one<1>(o[1], vb, pa0, pa1, pa2, pa3); pv_one<2>(o[2], vb, pa0, pa1, pa2, pa3); pv_one<3>(o[3], vb, pa0, pa1, pa2, pa3);
}
__device__ __forceinline__ void qkt(f32x16& p0, f32x16& p1, const LAS char* Ks, const bf16x8* qr, int r32, int hi) {
  p0 = f32x16{}; p1 = f32x16{};
#pragma unroll
  for (int d0 = 0; d0 < 8; ++d0) { const int cb = (d0 * 16 + hi * 8) * 2;
    const bf16x8 b0 = *(const LAS bf16x8*)(Ks + KSWZ(r32, cb));
    const bf16x8 b1 = *(const LAS bf16x8*)(Ks + KSWZ(32 + r32, cb));
    p0 = __builtin_amdgcn_mfma_f32_32x32x16_bf16(b0, qr[d0], p0, 0, 0, 0);
    p1 = __builtin_amdgcn_mfma_f32_32x32x16_bf16(b1, qr[d0], p1, 0, 0, 0); }
}
template <int WIN, bool ALIBI>
__device__ __forceinline__ void partialSM(f32x16& p0, f32x16& p1, float& m_reg, float& mn, float& alpha, float dub, float nslope, float lo, float hi_, bool tile_ok) {
  if (ALIBI || WIN) {
#pragma unroll
    for (int r = 0; r < 16; ++r) { const float c = (float)((r & 3) + 8 * (r >> 2)); const float du0 = dub + c, du1 = dub + (c + 32.f);
      float t0 = p0[r], t1 = p1[r];
      if (ALIBI) { t0 = fmaf(fabsf(du0), nslope, t0); t1 = fmaf(fabsf(du1), nslope, t1); }
      if (WIN) { t0 = (du0 >= lo && du0 <= hi_) ? t0 : -INFINITY; t1 = (du1 >= lo && du1 <= hi_) ? t1 : -INFINITY; }
      p0[r] = t0; p1[r] = t1; }
    if (WIN) { if (!tile_ok) {
#pragma unroll
      for (int r = 0; r < 16; ++r) { p0[r] = -INFINITY; p1[r] = -INFINITY; } } }
  }
  float pmax = p0[0];
#pragma unroll
  for (int r = 1; r < 16; ++r) pmax = fmaxf(pmax, p0[r]);
#pragma unroll
  for (int r = 0; r < 16; ++r) pmax = fmaxf(pmax, p1[r]);
  { auto rr = __builtin_amdgcn_permlane32_swap(__float_as_uint(pmax), __float_as_uint(pmax), false, false);
    pmax = fmaxf(__uint_as_float(rr[0]), __uint_as_float(rr[1])); }
  if (__builtin_expect(__all(pmax - m_reg <= THR2), 1)) { mn = m_reg; alpha = 1.f; }
  else { mn = fmaxf(m_reg, pmax); alpha = __builtin_amdgcn_exp2f(m_reg - mn); m_reg = mn; }
#pragma unroll
  for (int r = 0; r < 16; ++r) { p0[r] = p0[r] - mn; p1[r] = p1[r] - mn; }
#pragma unroll
  for (int r = 0; r < 16; ++r) p0[r] = __builtin_amdgcn_exp2f(p0[r]);
}
template <bool ALIBI>
__device__ __forceinline__ void pv_psm(f32x16* o, int vb, bf16x8 pa0, bf16x8 pa1, bf16x8 pa2, bf16x8 pa3, f32x16& p0, f32x16& p1, float& m_reg, float& mn, float& alpha, float dub, float nslope) {
  pv_one<0>(o[0], vb, pa0, pa1, pa2, pa3);
  if (ALIBI) {
#pragma unroll
    for (int r = 0; r < 16; ++r) { const float c = (float)((r & 3) + 8 * (r >> 2)); p0[r] = fmaf(fabsf(dub + c), nslope, p0[r]); p1[r] = fmaf(fabsf(dub + (c + 32.f)), nslope, p1[r]); } }
  float pmax = p0[0];
#pragma unroll
  for (int r = 1; r < 16; ++r) pmax = fmaxf(pmax, p0[r]);
  pv_one<1>(o[1], vb, pa0, pa1, pa2, pa3);
#pragma unroll
  for (int r = 0; r < 16; ++r) pmax = fmaxf(pmax, p1[r]);
  { auto rr = __builtin_amdgcn_permlane32_swap(__float_as_uint(pmax), __float_as_uint(pmax), false, false);
    pmax = fmaxf(__uint_as_float(rr[0]), __uint_as_float(rr[1])); }
  { const bool keep = __all(pmax - m_reg <= THR2); const float mnew = fmaxf(m_reg, pmax); mn = keep ? m_reg : mnew; alpha = __builtin_amdgcn_exp2f(m_reg - mn); m_reg = mn; }
#pragma unroll
  for (int r = 0; r < 16; ++r) p0[r] = p0[r] - mn;
  pv_one<2>(o[2], vb, pa0, pa1, pa2, pa3);
#pragma unroll
  for (int r = 0; r < 16; ++r) p1[r] = p1[r] - mn;
#pragma unroll
  for (int r = 0; r < 8; ++r) p0[r] = __builtin_amdgcn_exp2f(p0[r]);
  pv_one<3>(o[3], vb, pa0, pa1, pa2, pa3);
#pragma unroll
  for (int r = 8; r < 16; ++r) p0[r] = __builtin_amdgcn_exp2f(p0[r]);
}
__device__ __forceinline__ void finishSM(f32x16& p0, f32x16& p1, float alpha, float& l_reg, bf16x8& pa0, bf16x8& pa1, bf16x8& pa2, bf16x8& pa3) {
#pragma unroll
  for (int r = 0; r < 16; ++r) p1[r] = __builtin_amdgcn_exp2f(p1[r]);
  float ps = 0;
#pragma unroll
  for (int r = 0; r < 16; ++r) ps += p0[r];
#pragma unroll
  for (int r = 0; r < 16; ++r) ps += p1[r];
  { auto rr = __builtin_amdgcn_permlane32_swap(__float_as_uint(ps), __float_as_uint(ps), false, false);
    ps = __uint_as_float(rr[0]) + __uint_as_float(rr[1]); }
  l_reg = l_reg * alpha + ps;
#define PK4(P, BASE, OUT) do { unsigned a0 = cvt_pk_bf16(P[BASE + 0], P[BASE + 1]), a1 = cvt_pk_bf16(P[BASE + 2], P[BASE + 3]);   \
    unsigned b0 = cvt_pk_bf16(P[BASE + 4], P[BASE + 5]), b1 = cvt_pk_bf16(P[BASE + 6], P[BASE + 7]);                              \
    auto r0 = __builtin_amdgcn_permlane32_swap(a0, b0, false, false); auto r1 = __builtin_amdgcn_permlane32_swap(a1, b1, false, false); \
    u32x4 w = {r0[0], r1[0], r0[1], r1[1]}; OUT = *reinterpret_cast<bf16x8*>(&w); } while (0)
  PK4(p0, 0, pa0); PK4(p0, 8, pa1); PK4(p1, 0, pa2); PK4(p1, 8, pa3);
#undef PK4
}
struct Item {
  const bf16_t* qkv; int W;
  bf16_t* O; int ocol;
  float* lse; int hh;
  int seq_base, SU, dil, c0, u0, ukb0, NT, two;
  int qcol, kcol, vcol;
  float nslope, sink2, nlam;
  const float* kmax2;
  const float* subg;
  const float* ropetab; const float* qgain;
};
template <int WIN, bool ALIBI, int EPI, bool SINK>
__device__ __forceinline__ void attn_item(const Item& I, char* lds, int tid_in) {
  int tid = tid_in; asm volatile("" : "+v"(tid));
  const int wid = __builtin_amdgcn_readfirstlane(tid >> 6), lane = tid & 63, r32 = lane & 31, hi = lane >> 5;
  LAS char* V_lds = (LAS char*)lds; LAS char* K_lds = V_lds + 2 * SHM_V;
  LAS float* wsf = (LAS float*)(V_lds + (WIN ? 4 : 2) * (SHM_V + SHM_K)) + wid * 64; LAS float* li_l = wsf; LAS float* al_l = wsf + 32;
  float m_reg = SINK ? I.sink2 : -1e30f, l_reg = SINK ? 1.f : 0.f; f32x16 o[4] = {}; bf16x8 qr[8];
  const int two = I.two;
  const int wcls = two ? (wid >> 2) : 0;
  const int uq = I.u0 + (two ? ((wid & 3) * 32 + r32) : (wid * 32 + r32));
  { const bf16_t* Qw = I.qkv + (size_t)(I.seq_base + I.c0 + wcls + I.dil * uq) * I.W + I.qcol + hi * 8;
#pragma unroll
    for (int d0 = 0; d0 < 8; ++d0) qr[d0] = LDG(bf16x8, Qw + d0 * 16); }
  if constexpr (WIN == 0 && !ALIBI) { if (I.ropetab) {
#define BF2F(v) __uint_as_float((unsigned)(unsigned short)(v) << 16)
    float ss = 0.f;
#pragma unroll
    for (int d0 = 0; d0 < 8; ++d0)
#pragma unroll
      for (int e = 0; e < 8; ++e) { const float x = BF2F(qr[d0][e]); ss = fmaf(x, x, ss); }
    { auto rr = __builtin_amdgcn_permlane32_swap(__float_as_uint(ss), __float_as_uint(ss), false, false); ss = __uint_as_float(rr[0]) + __uint_as_float(rr[1]); }
    const float rs = QSCALE / sqrtf(ss * (1.f / 128.f) + EPS);
#pragma unroll
    for (int ax = 0; ax < 2; ++ax) { const int pos = ax ? (uq & 63) : (uq >> 6);
#pragma unroll
      for (int pi = 0; pi < 2; ++pi) { const int dl = 4 * ax + pi, dh = dl + 2;
        const float* tp = I.ropetab + (size_t)(pos * 32 + pi * 16 + hi * 8) * 2; const float* gl = I.qgain + dl * 16 + hi * 8; const float* gh = I.qgain + dh * 16 + hi * 8;
        const f32x4 t0 = LDG(f32x4, tp), t1 = LDG(f32x4, tp + 4), t2 = LDG(f32x4, tp + 8), t3 = LDG(f32x4, tp + 12);
        const f32x4 ga = LDG(f32x4, gl), gb = LDG(f32x4, gl + 4), gc = LDG(f32x4, gh), gd = LDG(f32x4, gh + 4);
        const float cs[8] = {t0[0], t0[2], t1[0], t1[2], t2[0], t2[2], t3[0], t3[2]}, sn[8] = {t0[1], t0[3], t1[1], t1[3], t2[1], t2[3], t3[1], t3[3]};
        const float gL[8] = {ga[0], ga[1], ga[2], ga[3], gb[0], gb[1], gb[2], gb[3]}, gH[8] = {gc[0], gc[1], gc[2], gc[3], gd[0], gd[1], gd[2], gd[3]};
        unsigned wl[4], wh[4];
#pragma unroll
        for (int e2 = 0; e2 < 4; ++e2) { float ol[2], oh[2];
#pragma unroll
          for (int q = 0; q < 2; ++q) { const int e = 2 * e2 + q; const float yl = BF2F(qr[dl][e]) * rs * gL[e], yh = BF2F(qr[dh][e]) * rs * gH[e];
            ol[q] = yl * cs[e] - yh * sn[e]; oh[q] = yh * cs[e] + yl * sn[e]; }
          wl[e2] = cvt_pk_bf16(ol[0], ol[1]); wh[e2] = cvt_pk_bf16(oh[0], oh[1]); }
        { u32x4 w = {wl[0], wl[1], wl[2], wl[3]}; qr[dl] = *reinterpret_cast<bf16x8*>(&w); }
        { u32x4 w = {wh[0], wh[1], wh[2], wh[3]}; qr[dh] = *reinterpret_cast<bf16x8*>(&w); } } }
#undef BF2F
  } }
  const int uqw = I.u0 + (two ? (wid & 3) * 32 : wid * 32);
  float lse_old = 0.f;
  if (EPI == 2) { if (hi == 0) lse_old = LDG(float, I.lse + (size_t)(I.seq_base + I.c0 + wcls + I.dil * uq) * 16 + I.hh); }
  const float lo = WIN ? (float)max(-WIN, -uq) : 0.f, hi_ = WIN ? (float)min(WIN, I.SU - 1 - uq) : 0.f;
  const float dq = (float)(4 * hi - uq);
  const int sr = tid >> 4, sc = (tid & 15) * 8, vst0 = v_st(sr, sc), vst1 = v_st(32 + sr, sc);
  const int vb0 = (int)(unsigned)(uintptr_t)V_lds + v_rd_base(lane);
  struct { bf16x8 vs0, vs1, ks0, ks1; } sr_[2];
#define TILE_UKB(n) (two ? 64 * ((n) & 1) : I.ukb0 + 64 * (n))
#define TILE_OK(n) (!two || ((n) >> 1) == (wid >> 2))
#define ACT(n) (!WIN || (TILE_OK(n) && TILE_UKB(n) + 63 >= uqw - WIN && TILE_UKB(n) <= uqw + 31 + WIN))
#define SLOAD(i, n) do { const int ukb_ = TILE_UKB(n); const int cls_ = I.c0 + (two ? ((n) >> 1) : 0); int u0_ = ukb_ + sr, u1_ = ukb_ + 32 + sr; \
    if (WIN) { u0_ = min(max(u0_, 0), I.SU - 1); u1_ = min(max(u1_, 0), I.SU - 1); } \
    const bf16_t* r0_ = I.qkv + (size_t)(I.seq_base + cls_ + I.dil * u0_) * I.W + sc; const bf16_t* r1_ = I.qkv + (size_t)(I.seq_base + cls_ + I.dil * u1_) * I.W + sc; \
    sr_[i].vs0 = LDG(bf16x8, r0_ + I.vcol); sr_[i].vs1 = LDG(bf16x8, r1_ + I.vcol); \
    sr_[i].ks0 = LDG(bf16x8, r0_ + I.kcol); sr_[i].ks1 = LDG(bf16x8, r1_ + I.kcol); } while (0)
#define SWRITE(b, i) do { *(LAS bf16x8*)(V_lds + (b) * SHM_V + vst0) = sr_[i].vs0; *(LAS bf16x8*)(V_lds + (b) * SHM_V + vst1) = sr_[i].vs1; const int kc = sc * 2; \
    *(LAS bf16x8*)(K_lds + (b) * SHM_K + KSWZ(sr, kc)) = sr_[i].ks0; *(LAS bf16x8*)(K_lds + (b) * SHM_K + KSWZ(32 + sr, kc)) = sr_[i].ks1; } while (0)
#define SWAIT() asm volatile("s_waitcnt vmcnt(4)" ::: "memory")
#define RESC(a) do { if (__any((a) < 1.f)) { if (hi == 0) al_l[r32] = (a); asm volatile("s_waitcnt lgkmcnt(0)" ::: "memory"); \
    _Pragma("unroll") for (int d = 0; d < 4; ++d) _Pragma("unroll") for (int r = 0; r < 16; ++r) o[d][r] *= al_l[crow(r, hi)]; } } while (0)
#define PSM(P0, P1, MN, AL, n) partialSM<WIN, ALIBI>(P0, P1, m_reg, MN, AL, dq + (float)TILE_UKB(n), I.nslope, lo, hi_, TILE_OK(n))
  f32x16 pA0, pA1, pB0, pB1; float mnA, mnB, alA, alB; bf16x8 pa0, pa1, pa2, pa3; const int NT = I.NT;
  constexpr int SE = 0, SO = 1;
  if constexpr (WIN == 0) {
  SLOAD(SE, 0); asm volatile("s_waitcnt vmcnt(0)" ::: "memory"); SWRITE(0, SE); __syncthreads();
  qkt(pA0, pA1, K_lds, qr, r32, hi); PSM(pA0, pA1, mnA, alA, 0);
  SLOAD(SO, 1); if (2 < NT) SLOAD(SE, 2);
  SWAIT(); SWRITE(1, SO); __syncthreads();
  for (int j = 1; j + 1 < NT; j += 2) {
    SBAR(); qkt(pB0, pB1, K_lds + SHM_K, qr, r32, hi);
    finishSM(pA0, pA1, alA, l_reg, pa0, pa1, pa2, pa3); SBAR();
    SLOAD(SO, j + 2); SBAR();
    pv_psm<ALIBI>(o, vb0, pa0, pa1, pa2, pa3, pB0, pB1, m_reg, mnB, alB, dq + (float)TILE_UKB(j), I.nslope);
    __syncthreads(); SWAIT(); SWRITE(0, SE);
    RESC(alB); __syncthreads();
    SBAR(); qkt(pA0, pA1, K_lds, qr, r32, hi);
    finishSM(pB0, pB1, alB, l_reg, pa0, pa1, pa2, pa3); SBAR();
    if (j + 3 < NT) SLOAD(SE, j + 3); SBAR();
    pv_psm<ALIBI>(o, vb0 + SHM_V, pa0, pa1, pa2, pa3, pA0, pA1, m_reg, mnA, alA, dq + (float)TILE_UKB(j + 1), I.nslope);
    __syncthreads(); SWAIT(); SWRITE(1, SO);
    RESC(alA); __syncthreads();
  }
  SBAR(); qkt(pB0, pB1, K_lds + SHM_K, qr, r32, hi);
  finishSM(pA0, pA1, alA, l_reg, pa0, pa1, pa2, pa3); SBAR();
  pv_psm<ALIBI>(o, vb0, pa0, pa1, pa2, pa3, pB0, pB1, m_reg, mnB, alB, dq + (float)TILE_UKB(NT - 1), I.nslope);
  __syncthreads(); RESC(alB);
  finishSM(pB0, pB1, alB, l_reg, pa0, pa1, pa2, pa3); SBAR();
  pv_d0(o, vb0 + SHM_V, pa0, pa1, pa2, pa3);
  } else {
  const int hh = wid >> 2, tl = tid & 255, sr4 = tl >> 4, sc4 = (tl & 15) * 8;
  LAS char* Vh = V_lds + hh * (2 * (SHM_V + SHM_K)); LAS char* Kh = Vh + 2 * SHM_V;
  const int vbh = (int)(unsigned)(uintptr_t)Vh + v_rd_base(lane);
  const int clsw = I.c0 + wcls, NTw = two ? 2 : (128 + 2 * WIN) / 64, ukbw = two ? 0 : I.u0 + 128 * hh - WIN;
  bf16x8 stv[4], stk[4];
#define WUKB(n) (ukbw + 64 * (n))
#define WACT(n) (WUKB(n) + 63 >= uqw - WIN && WUKB(n) <= uqw + 31 + WIN)
#define WSLOAD(n) do { _Pragma("unroll") for (int i_ = 0; i_ < 4; ++i_) { int u_ = WUKB(n) + sr4 + 16 * i_; u_ = min(max(u_, 0), I.SU - 1); \
      const bf16_t* rp_ = I.qkv + (size_t)(I.seq_base + clsw + I.dil * u_) * I.W + sc4; stv[i_] = LDG(bf16x8, rp_ + I.vcol); stk[i_] = LDG(bf16x8, rp_ + I.kcol); } } while (0)
#define WSWRITE(b) do { _Pragma("unroll") for (int i_ = 0; i_ < 4; ++i_) { *(LAS bf16x8*)(Vh + (b) * SHM_V + v_st(sr4 + 16 * i_, sc4)) = stv[i_]; \
      *(LAS bf16x8*)(Kh + (b) * SHM_K + KSWZ(sr4 + 16 * i_, sc4 * 2)) = stk[i_]; } } while (0)
  WSLOAD(0); asm volatile("s_waitcnt vmcnt(0)" ::: "memory"); WSWRITE(0); if (1 < NTw) WSLOAD(1); __syncthreads();
  for (int n = 0; n < NTw; ++n) { const int bsel = n & 1;
    if (WACT(n)) { qkt(pA0, pA1, Kh + bsel * SHM_K, qr, r32, hi);
      partialSM<WIN, ALIBI>(pA0, pA1, m_reg, mnA, alA, dq + (float)WUKB(n), I.nslope, lo, hi_, true); RESC(alA);
      finishSM(pA0, pA1, alA, l_reg, pa0, pa1, pa2, pa3); SBAR(); pv_d0(o, vbh + bsel * SHM_V, pa0, pa1, pa2, pa3); }
    if (n + 1 < NTw) { asm volatile("s_waitcnt vmcnt(0)" ::: "memory"); WSWRITE(bsel ^ 1); if (n + 2 < NTw) WSLOAD(n + 2); }
    __syncthreads();
  }
#undef WUKB
#undef WACT
#undef WSLOAD
#undef WSWRITE
  }
  const int tokq = I.seq_base + I.c0 + wcls + I.dil * uq;
  if (EPI == 0 || EPI == 1 || EPI == 3 || EPI == 4 || EPI == 5) { if (hi == 0) { li_l[r32] = ((EPI == 3 || EPI == 5) ? I.nlam : 1.f) / l_reg; if (EPI == 1) STG(float, I.lse + (size_t)tokq * 16 + I.hh) = m_reg + __log2f(l_reg); } }
  if (EPI == 2) { if (hi == 0) { float* lp = I.lse + (size_t)tokq * 16 + I.hh; const float lold = lse_old, lcur = m_reg + __log2f(l_reg), mx = fmaxf(lold, lcur);
      const float wa = __builtin_amdgcn_exp2f(lold - mx), wb = __builtin_amdgcn_exp2f(lcur - mx), den = wa + wb; STG(float, lp) = mx + __log2f(den);
      al_l[r32] = wa / den; li_l[r32] = wb / (den * l_reg); } }
  asm volatile("s_waitcnt lgkmcnt(0)" ::: "memory");
  const int tokw = I.seq_base + I.c0 + wcls + I.dil * (I.u0 + (two ? (wid & 3) * 32 : wid * 32));
  bf16_t* Ow = I.O + (size_t)tokw * DM + I.ocol + r32;
  LAS unsigned* park = (LAS unsigned*)(V_lds + 2 * SHM_V + 2 * SHM_K + 2048) + tid * 32;
  if constexpr (EPI == 4) {
#pragma unroll
    for (int r = 0; r < 16; r += 2) { const float f0 = li_l[crow(r, hi)], f1 = li_l[crow(r + 1, hi)];
#pragma unroll
      for (int d0 = 0; d0 < 4; ++d0) park[(r >> 1) * 4 + d0] = cvt_pk_bf16(o[d0][r] * f0, o[d0][r + 1] * f1); }
  } else if constexpr (EPI == 3) {
    unsigned oldv[16][4];
#pragma unroll
    for (int r = 0; r < 16; ++r) { const bf16_t* Or = Ow + (size_t)(I.dil * crow(r, hi)) * DM;
#pragma unroll
      for (int d0 = 0; d0 < 4; ++d0) oldv[r][d0] = (unsigned)LDG(bf16_t, Or + d0 * 32); }
    asm volatile("" ::: "memory");
#pragma unroll
    for (int r = 0; r < 16; ++r) { const int orow = crow(r, hi); const float f = li_l[orow];
      bf16_t* Or = Ow + (size_t)(I.dil * orow) * DM;
#pragma unroll
      for (int d0 = 0; d0 < 4; ++d0) { const float v = __uint_as_float(oldv[r][d0] << 16) + o[d0][r] * f;
        STG(bf16_t, Or + d0 * 32) = (bf16_t)(cvt_pk_bf16(v, v) & 0xffffu); } }
  } else {
    const int rsub = lane >> 4, ch = lane & 15;
    bf16_t* Orow = I.O + (size_t)tokw * DM + I.ocol + ch * 8;
    u32x4 oldv[(EPI == 2) ? 8 : 1];
    if constexpr (EPI == 2) {
#pragma unroll
      for (int j = 0; j < 8; ++j) oldv[j] = LDG(u32x4, Orow + (size_t)(I.dil * (4 * j + rsub)) * DM); }
    __syncthreads();
    constexpr int RB = (EPI == 2) ? 512 : 256;
    LAS char* Sw = V_lds + wid * (32 * RB);
    if constexpr (EPI == 5) {
#pragma unroll
      for (int r = 0; r < 16; r += 2) { const int or0 = crow(r, hi), or1 = crow(r + 1, hi); const float f0 = li_l[or0], f1 = li_l[or1];
#pragma unroll
        for (int d0 = 0; d0 < 4; ++d0) { const unsigned pk = park[(r >> 1) * 4 + d0]; const float v0 = bf_lo(pk) + o[d0][r] * f0, v1 = bf_hi(pk) + o[d0][r + 1] * f1;
          const unsigned w = cvt_pk_bf16(v0, v1);
          *(LAS bf16_t*)(Sw + or0 * RB + (d0 * 32 + r32) * 2) = (bf16_t)(w & 0xffffu); *(LAS bf16_t*)(Sw + or1 * RB + (d0 * 32 + r32) * 2) = (bf16_t)(w >> 16); } }
    } else {
#pragma unroll
      for (int r = 0; r < 16; ++r) { const int orow = crow(r, hi); const float f = li_l[orow];
#pragma unroll
        for (int d0 = 0; d0 < 4; ++d0) { const float v = o[d0][r] * f;
          if constexpr (EPI == 2) *(LAS float*)(Sw + orow * RB + (d0 * 32 + r32) * 4) = v;
          else *(LAS bf16_t*)(Sw + orow * RB + (d0 * 32 + r32) * 2) = (bf16_t)(cvt_pk_bf16(v, v) & 0xffffu); } }
    }
    asm volatile("s_waitcnt lgkmcnt(0)" ::: "memory");
    if constexpr (EPI == 2) {
#pragma unroll
      for (int j = 0; j < 8; ++j) { const int row = 4 * j + rsub; const float fo = al_l[row];
        const f32x4 a0 = *(const LAS f32x4*)(Sw + row * RB + ch * 32), a1 = *(const LAS f32x4*)(Sw + row * RB + ch * 32 + 16); const u32x4 ov = oldv[j];
        u32x4 w; w.x = cvt_pk_bf16(fo * bf_lo(ov.x) + a0[0], fo * bf_hi(ov.x) + a0[1]); w.y = cvt_pk_bf16(fo * bf_lo(ov.y) + a0[2], fo * bf_hi(ov.y) + a0[3]);
        w.z = cvt_pk_bf16(fo * bf_lo(ov.z) + a1[0], fo * bf_hi(ov.z) + a1[1]); w.w = cvt_pk_bf16(fo * bf_lo(ov.w) + a1[2], fo * bf_hi(ov.w) + a1[3]);
        STG(u32x4, Orow + (size_t)(I.dil * row) * DM) = w; }
    } else {
#pragma unroll
      for (int j = 0; j < 8; ++j) { const int row = 4 * j + rsub; const u32x4 w = *(const LAS u32x4*)(Sw + row * RB + ch * 16);
        STG(u32x4, Orow + (size_t)(I.dil * row) * DM) = w; }
    }
  }
  __syncthreads();
#undef TILE_UKB
#undef TILE_OK
#undef ACT
#undef SLOAD
#undef SWRITE
#undef SWAIT
#undef RESC
#undef PSM
}
template <int EPI>
__device__ __forceinline__ void attn_item_c(const Item& I, char* lds, int tid_in) {
  int tid = tid_in; asm volatile("" : "+v"(tid));
  const int wid = __builtin_amdgcn_readfirstlane(tid >> 6), lane = tid & 63, r32 = lane & 31, hi = lane >> 5;
  constexpr int STG = 3 * SHM_V;
  LAS char* base = (LAS char*)lds;
  LAS float* wsf = (LAS float*)(base + 131072) + wid * 64; LAS float* li_l = wsf; LAS float* al_l = wsf + 32;
  float m_reg = -1e30f, l_reg = 0.f; f32x16 oA[4] = {}, oB[4] = {}; bf16x8 qr[8];
  const int uq = I.u0 + wid * 32 + r32;
  { const bf16_t* Qw = I.qkv + (size_t)(I.seq_base + uq) * I.W + I.qcol + hi * 8;
#pragma unroll
    for (int d0 = 0; d0 < 8; ++d0) qr[d0] = LDG(bf16x8, Qw + d0 * 16); }
  const float dq = (float)(4 * hi - uq);
  const int vb0 = (int)(unsigned)(uintptr_t)base + v_rd_base(lane);
  unsigned gk[2], gv[2];
#pragma unroll
  for (int i = 0; i < 2; ++i) { const int p = i * 8192 + wid * 1024 + lane * 16;
    { const int row = p >> 8, chunk = ((p & 255) >> 4) ^ (row & 7); gk[i] = (unsigned)(row * I.W + chunk * 8) * 2u; }
    { const int sub = p >> 9, within = p & 511, kk = (sub >> 2) * 8 + (within >> 6), k = (kk & ~0xC) | ((kk & 4) << 1) | ((kk & 8) >> 1), c = (sub & 3) * 32 + ((within & 63) >> 1);
      gv[i] = (unsigned)(k * I.W + c) * 2u; } }
  const char* kvb = (const char*)(I.qkv + (size_t)I.seq_base * I.W);
#define CDMA(n, b) do { const char* tb_ = kvb + (size_t)(64 * (n)) * I.W * 2; const char* vbp_ = tb_ + I.vcol * 2; const char* kbp_ = tb_ + I.kcol * 2; LAS char* s_ = base + (b) * STG + wid * 1024; \
    _Pragma("unroll") for (int i_ = 0; i_ < 2; ++i_) { \
      __builtin_amdgcn_global_load_lds((const unsigned*)(vbp_ + gv[i_]), (LAS unsigned*)(s_ + i_ * 8192), 16, 0, 0); \
      __builtin_amdgcn_global_load_lds((const unsigned*)(vbp_ + 256 + gv[i_]), (LAS unsigned*)(s_ + SHM_V + i_ * 8192), 16, 0, 0); \
      __builtin_amdgcn_global_load_lds((const unsigned*)(kbp_ + gk[i_]), (LAS unsigned*)(s_ + 2 * SHM_V + i_ * 8192), 16, 0, 0); } } while (0)
  f32x16 p0, p1; float mn, al; bf16x8 pa0, pa1, pa2, pa3; const int NT = I.NT;
  const int n0 = I.u0 >> 6, ntm = NT - 1;
#define CT(n) (((n) + n0) & ntm)
  CDMA(CT(0), 0);
  m_reg = 0.f;
  { const float dubn = dq + (float)(64 * CT(0)), nslope = I.nslope, negm = 0.f;
    BI2(0); BI2(1); BI2(2); BI2(3); BI2(4); BI2(5); BI2(6); BI2(7); BI2(8); BI2(9); BI2(10); BI2(11); BI2(12); BI2(13); BI2(14); BI2(15); }
  LAS float* xw = (LAS float*)(base + 133184);
  { float qs = 0.f;
#pragma unroll
    for (int d0 = 0; d0 < 8; ++d0)
#pragma unroll
      for (int j = 0; j < 8; ++j) { const float x = __uint_as_float((unsigned)(unsigned short)qr[d0][j] << 16); qs = fmaf(x, x, qs); }
    { auto rr = __builtin_amdgcn_permlane32_swap(__float_as_uint(qs), __float_as_uint(qs), false, false); qs = __uint_as_float(rr[0]) + __uint_as_float(rr[1]); }
    qs = wave_max(qs); if (lane == 0) xw[wid] = qs; }
  asm volatile("s_waitcnt vmcnt(0)" ::: "memory"); __syncthreads();
  float qkb;
  { float q2 = xw[0];
#pragma unroll
    for (int w = 1; w < 8; ++w) q2 = fmaxf(q2, xw[w]);
    qkb = __uint_as_float(__builtin_amdgcn_readfirstlane(__float_as_uint(1.01f * sqrtf(q2 * LDG(float, I.kmax2))))); }
  int R = NT, Lw = 0;
  for (int n = 0, step = 0;; ++step) { const int bsel = step & 1;
    if (step == 4) { float ml = xw[8];
#pragma unroll
      for (int w = 1; w < 8; ++w) ml = fminf(ml, xw[8 + w]);
      const float dmax = fminf((152.f + qkb - ml) / -I.nslope, 1e6f);
      const int cnt = __builtin_amdgcn_readfirstlane(dmax > 0.f ? (int)((dmax + 63.f) * (1.f / 64.f)) : 0);
      R = 3 + min(cnt, NT - n0 - 4); Lw = min(cnt, n0); }
    int nn = n + 1; if (nn > 4 && nn > R && nn < NT - Lw) nn = NT - Lw;
    const bool last = nn >= NT; const int nf = last ? n : nn;
    { const char* tb_ = kvb + (size_t)(64 * CT(nf)) * I.W * 2; const char* vbp_ = tb_ + I.vcol * 2; const char* kbp_ = tb_ + I.kcol * 2; LAS char* s_ = base + (bsel ^ 1) * STG + wid * 1024;
      qkt_pipe<false>(p0, p1, base + bsel * STG + 2 * SHM_V, qr, r32, hi, [&](int st) {
        if (st == 0) __builtin_amdgcn_global_load_lds((const unsigned*)(kbp_ + gk[0]), (LAS unsigned*)(s_ + 2 * SHM_V), 16, 0, 0);
        if (st == 1) __builtin_amdgcn_global_load_lds((const unsigned*)(kbp_ + gk[1]), (LAS unsigned*)(s_ + 2 * SHM_V + 8192), 16, 0, 0);
        if (st == 2) __builtin_amdgcn_global_load_lds((const unsigned*)(vbp_ + gv[0]), (LAS unsigned*)(s_), 16, 0, 0);
        if (st == 3) __builtin_amdgcn_global_load_lds((const unsigned*)(vbp_ + gv[1]), (LAS unsigned*)(s_ + 8192), 16, 0, 0);
        if (st == 4) __builtin_amdgcn_global_load_lds((const unsigned*)(vbp_ + 256 + gv[0]), (LAS unsigned*)(s_ + SHM_V), 16, 0, 0);
        if (st == 5) __builtin_amdgcn_global_load_lds((const unsigned*)(vbp_ + 256 + gv[1]), (LAS unsigned*)(s_ + SHM_V + 8192), 16, 0, 0); }); }
    float pmax = fmaxf(p0[0], p1[0]);
#pragma unroll
    for (int r = 1; r < 16; ++r) pmax = fmaxf(fmaxf(pmax, p0[r]), p1[r]);
    { auto rr = __builtin_amdgcn_permlane32_swap(__float_as_uint(pmax), __float_as_uint(pmax), false, false);
      pmax = fmaxf(__uint_as_float(rr[0]), __uint_as_float(rr[1])); }
    al = 1.f;
    if (step == 0 || !__all(pmax <= THR2)) {
      const float delta = (step == 0) ? pmax : fmaxf(pmax, 0.f); al = (step == 0) ? 1.f : __builtin_amdgcn_exp2f(-delta); m_reg += delta;
#pragma unroll
      for (int r = 0; r < 16; ++r) { p0[r] -= delta; p1[r] -= delta; }
      if (hi == 0) al_l[r32] = al; asm volatile("s_waitcnt lgkmcnt(0)" ::: "memory");
#pragma unroll
      for (int d = 0; d < 4; ++d)
#pragma unroll
        for (int r = 0; r < 16; ++r) { const float a_ = al_l[crow(r, hi)]; oA[d][r] *= a_; oB[d][r] *= a_; } }
    if (step == 3) { const float wm = -wave_max(-m_reg); if (lane == 0) xw[8 + wid] = wm; }
#pragma unroll
    for (int r = 0; r < 16; ++r) p0[r] = __builtin_amdgcn_exp2f(p0[r]);
    finishSM(p0, p1, al, l_reg, pa0, pa1, pa2, pa3); SBAR();
    pv_pipe8b(oA, oB, vb0 + bsel * STG, vb0 + bsel * STG + SHM_V, pa0, pa1, pa2, pa3, p0, p1, dq + (float)(64 * CT(nf)), I.nslope, -m_reg);
    asm volatile("s_waitcnt vmcnt(0)" ::: "memory");
    __syncthreads();
    if (last) break;
    n = nn;
  }
#undef CDMA
#undef CT
#undef BI2
  if (hi == 0) li_l[r32] = ((EPI == 3) ? ((LAS float*)(base + 133120))[wid] : 1.f) / l_reg;
  asm volatile("s_waitcnt lgkmcnt(0)" ::: "memory");
  const int tokw = I.seq_base + I.u0 + wid * 32;
  constexpr int RB = (EPI == 3) ? 512 : 256;
  LAS char* Sw = base + wid * (32 * RB);
  const int rsub = lane >> 4, ch = lane & 15;
  f32x4 dv[2][8][2];
#pragma unroll
  for (int half = 0; half < 2; ++half) {
    f32x16* o = half ? oB : oA;
    asm volatile("s_waitcnt lgkmcnt(0)" ::: "memory");
#pragma unroll
    for (int r = 0; r < 16; ++r) { const int orow = crow(r, hi); const float fq_ = li_l[orow];
#pragma unroll
      for (int d0 = 0; d0 < 4; ++d0) { const float v = o[d0][r] * fq_;
        if constexpr (EPI == 3) *(LAS float*)(Sw + orow * RB + (d0 * 32 + r32) * 4) = v;
        else *(LAS bf16_t*)(Sw + orow * RB + (d0 * 32 + r32) * 2) = (bf16_t)(cvt_pk_bf16(v, v) & 0xffffu); } }
    asm volatile("s_waitcnt lgkmcnt(0)" ::: "memory");
    bf16_t* Orow = I.O + (size_t)tokw * DM + I.ocol + half * 128 + ch * 8;
    if constexpr (EPI == 3) {
      u32x4 oldv[8];
#pragma unroll
      for (int j = 0; j < 8; ++j) oldv[j] = LDG(u32x4, Orow + (size_t)(4 * j + rsub) * DM);
      asm volatile("" ::: "memory");
#pragma unroll
      for (int j = 0; j < 8; ++j) { const int row = 4 * j + rsub;
        const f32x4 a0 = *(const LAS f32x4*)(Sw + row * RB + ch * 32), a1 = *(const LAS f32x4*)(Sw + row * RB + ch * 32 + 16); const u32x4 ov = oldv[j];
        dv[half][j][0] = (f32x4){bf_lo(ov.x) + a0[0], bf_hi(ov.x) + a0[1], bf_lo(ov.y) + a0[2], bf_hi(ov.y) + a0[3]};
        dv[half][j][1] = (f32x4){bf_lo(ov.z) + a1[0], bf_hi(ov.z) + a1[1], bf_lo(ov.w) + a1[2], bf_hi(ov.w) + a1[3]}; }
    } else {
#pragma unroll
      for (int j = 0; j < 8; ++j) { const int row = 4 * j + rsub; const u32x4 w = *(const LAS u32x4*)(Sw + row * RB + ch * 16);
        STG(u32x4, Orow + (size_t)row * DM) = w; }
    }
  }
  if constexpr (EPI == 3) {
    f32x4 gsl[2][2];
#pragma unroll
    for (int half = 0; half < 2; ++half) { gsl[half][0] = LDG(f32x4, I.subg + half * 128 + ch * 8) * (1.f - LAM_INIT2); gsl[half][1] = LDG(f32x4, I.subg + half * 128 + ch * 8 + 4) * (1.f - LAM_INIT2); }
#pragma unroll
    for (int j = 0; j < 8; ++j) { float ss = 0.f;
#pragma unroll
      for (int half = 0; half < 2; ++half)
#pragma unroll
        for (int q = 0; q < 2; ++q) { const f32x4 d = dv[half][j][q]; ss += (d[0] * d[0] + d[1] * d[1]) + (d[2] * d[2] + d[3] * d[3]); }
      ss += swz_xor<1>(ss); ss += swz_xor<2>(ss); ss += swz_xor<4>(ss); ss += swz_xor<8>(ss);
      const float rstd = 1.0f / sqrtf(ss * (1.f / 256.f) + EPS);
#pragma unroll
      for (int half = 0; half < 2; ++half) { const f32x4 y0 = dv[half][j][0] * rstd * gsl[half][0], y1 = dv[half][j][1] * rstd * gsl[half][1];
        u32x4 w; w.x = cvt_pk_bf16(y0[0], y0[1]); w.y = cvt_pk_bf16(y0[2], y0[3]); w.z = cvt_pk_bf16(y1[0], y1[1]); w.w = cvt_pk_bf16(y1[2], y1[3]);
        STG(u32x4, I.O + (size_t)(tokw + 4 * j + rsub) * DM + I.ocol + half * 128 + ch * 8) = w; } }
  }
  asm volatile("s_waitcnt vmcnt(0)" ::: "memory");
  __syncthreads();
}
#undef KSWZ
#undef SBAR
}

struct ItemId { int seq_base, S, h, qb; };
__device__ __forceinline__ ItemId item_decode(int it) { ItemId d;
  if (it < 2048) { d.S = SS_; d.seq_base = TOKP + (it >> 8) * SS_; d.h = (it >> 4) & 15; d.qb = it & 15; }
  else { const int r = it - 2048; d.S = SP_; d.seq_base = (r >> 7) * SP_; d.h = (r >> 3) & 15; d.qb = r & 7; }
  return d; }
template <int MODE> __device__ __forceinline__ void phase_attn_fast(const Frame& F0) {
  const Frame F = fresh(F0);
  float nlam = 0.f;
  if (MODE == 3 || MODE == 2) { const float* lp = argp(F, 16);
    const float d1 = wave_sum(lp[F.lane] * lp[128 + F.lane] + lp[64 + F.lane] * lp[192 + F.lane]);
    const float d2 = wave_sum(lp[256 + F.lane] * lp[384 + F.lane] + lp[320 + F.lane] * lp[448 + F.lane]);
    nlam = -(expf(d1) - expf(d2) + LAM_INIT2); }
  for (int i = 0;; ++i) {
    const int it = i * F.G + F.vcu; if (it >= 2560) break;
    const ItemId d = item_decode(it);
    fa::Item I; I.qkv = F.big; I.O = F.hbuf2; I.lse = F.lse; I.seq_base = d.seq_base; I.two = 0; I.dil = 1; I.c0 = 0; I.SU = d.S; I.u0 = 256 * d.qb; I.hh = d.h;
    I.nslope = 0.f; I.sink2 = 0.f; I.nlam = nlam; I.subg = nullptr; I.ropetab = nullptr; I.qgain = nullptr;
    if (MODE == 2 || MODE == 3) { const int hq = d.h >> 1, vh = d.h & 1, kvh = hq >> 1, mp = (MODE == 3) ? 1 : 0;
      I.W = 4096; I.qcol = hq * 256 + mp * 128; I.kcol = 2048 + kvh * 256 + mp * 128; I.vcol = 3072 + kvh * 256 + vh * 128; I.ocol = hq * 256 + vh * 128;
      I.nslope = -exp2f(-(float)(hq + 1)) * LOG2E; I.ukb0 = 0; I.NT = d.S / 64;
      if (MODE == 2) { fa::attn_item<0, true, 4, false>(I, (char*)F.lds, F.tid);
        I.qcol += 128; I.kcol += 128; fa::attn_item<0, true, 5, false>(I, (char*)F.lds, F.tid); }
      else fa::attn_item<0, true, 3, false>(I, (char*)F.lds, F.tid);
    } else { const int kvh = d.h >> 2; I.W = 3072; I.qcol = d.h * 128; I.kcol = 2048 + kvh * 128; I.vcol = 2560 + kvh * 128; I.ocol = d.h * 128;
      const float slope2 = exp2f(-0.5f * (float)(d.h + 1)) * LOG2E;
      if (MODE == 0) { I.ukb0 = 0; I.NT = d.S / 64; I.ropetab = (const float*)(F.ws + WS_ROPE); I.qgain = argp(F, 9); fa::attn_item<0, false, 0, false>(I, (char*)F.lds, F.tid); }
      if (MODE == 1) { I.ukb0 = I.u0 - 128; I.NT = 8; I.nslope = -slope2; I.sink2 = argp(F, 13)[d.h] * LOG2E; fa::attn_item<128, true, 0, true>(I, (char*)F.lds, F.tid); }
      if (MODE == 4) { I.ukb0 = I.u0 - 64; I.NT = 6; I.nslope = -slope2; fa::attn_item<64, true, 1, false>(I, (char*)F.lds, F.tid); }
      if (MODE == 5 || MODE == 6) { const int dil = (MODE == 5) ? 4 : 16; I.dil = dil; I.SU = d.S / dil; I.nslope = -slope2 * (float)dil;
        const int nqc = I.SU / 256;
        if (nqc == 0) { I.two = 1; I.c0 = 2 * d.qb; I.u0 = 0; I.ukb0 = 0; I.NT = 4; }
        else { I.c0 = d.qb / nqc; I.u0 = 256 * (d.qb % nqc); I.ukb0 = I.u0 - 64; I.NT = 6; }
        fa::attn_item<64, true, 2, false>(I, (char*)F.lds, F.tid); }
    }
  }
}
__device__ __forceinline__ void phase_kmax(const Frame& F0) {
  const Frame F = fresh(F0);
  unsigned* km = (unsigned*)(F.ws + WS_KMAX);
  for (int e = F.gw; e < (TOK / 64) * 8; e += F.NGW) { const int tile = e >> 3, kvh = (e >> 1) & 3, mp = e & 1;
    const bf16_t* kp = F.big + (size_t)(tile * 64 + F.lane) * 4096 + 2048 + kvh * 256 + mp * 128;
    float ss = 0.f;
#pragma unroll
    for (int c = 0; c < 16; ++c) { const bf16x8 v = LDG(bf16x8, kp + c * 8);
#pragma unroll
      for (int j = 0; j < 8; ++j) { const float x = __uint_as_float((unsigned)(unsigned short)v[j] << 16); ss = fmaf(x, x, ss); } }
    const float kmx = wave_max(ss);
    if (F.lane == 0) atomicMax(km + batch_of(tile * 64) * 8 + kvh * 2 + mp, __float_as_uint(kmx)); }
}
__device__ __forceinline__ void phase_attn_c(const Frame& F0) {
  const Frame F = fresh(F0);
  const float* lp = argp(F, 16);
  const float d1 = wave_sum(lp[F.lane] * lp[128 + F.lane] + lp[64 + F.lane] * lp[192 + F.lane]);
  const float d2 = wave_sum(lp[256 + F.lane] * lp[384 + F.lane] + lp[320 + F.lane] * lp[448 + F.lane]);
  { const float nl_ = -(expf(d1) - expf(d2) + LAM_INIT2); if (F.lane == 0) ((LAS float*)(F.lds + 133120))[F.wave] = nl_; }
  const float nlam = 0.f;
  const float* subg = argp(F, 17);
  unsigned* qc = (unsigned*)(F.ws + WS_CQ);
  const int q0 = (int)blockIdx.x & 7;
  LAS int* slot = (LAS int*)(F.lds + 133248);
  if (F.tid == 0) slot[2] = 0;
  for (int i = 0;; ++i) {
    if (F.tid == 0) { int qv = slot[2], w_ = -1;
      while (qv < 8) { const int qq = (q0 + qv) & 7; const int k_ = (int)atomicAdd(qc + qq * 32, 1u); if (k_ < 160) { w_ = qq * 256 + k_; break; } ++qv; }
      slot[2] = qv; slot[i & 1] = w_; }
    __syncthreads();
    const int w = __builtin_amdgcn_readfirstlane(slot[i & 1]); if (w < 0) break;
    const int q_ = w >> 8, seg = (w & 255) >> 5, j = w & 31;
    int seq_base, S, hq, qb;
    if (seg != 3) { const int kvh_ = (seg == 4) ? 0 : 3 - seg, i_ = (kvh_ - q_) & 3, t = j & 15;
      S = SS_; seq_base = TOKP + (2 * i_ + (q_ >> 2)) * SS_; hq = 2 * kvh_ + 1 - (j >> 4); qb = (t & 1) ? 8 + (t >> 1) : 7 - (t >> 1); }
    else { const int t = j & 7; S = SP_; seq_base = (q_ >> 1) * SP_; hq = 4 * (q_ & 1) + 3 - (j >> 3); qb = (t & 1) ? 4 + (t >> 1) : 3 - (t >> 1); }
    const int kvh = hq >> 1;
    fa::Item I; I.qkv = F.big; I.O = F.hbuf2; I.lse = F.lse; I.seq_base = seq_base; I.two = 0; I.dil = 1; I.c0 = 0; I.SU = S; I.u0 = 256 * qb; I.hh = 0; I.ukb0 = 0; I.NT = S / 64;
    I.W = 4096; I.qcol = hq * 256; I.kcol = 2048 + kvh * 256; I.vcol = 3072 + kvh * 256; I.ocol = hq * 256;
    I.nslope = -exp2f(-(float)(hq + 1)) * LOG2E; I.sink2 = 0.f; I.nlam = nlam; I.subg = subg;
    I.kmax2 = (const float*)(F.ws + WS_KMAX) + batch_of(seq_base) * 8 + kvh * 2;
    fa::attn_item_c<0>(I, (char*)F.lds, F.tid);
    I.qcol += 128; I.kcol += 128; I.kmax2 += 1;
    fa::attn_item_c<3>(I, (char*)F.lds, F.tid);
  }
}
__device__ __forceinline__ void phase_subln(const Frame& F0) {
  const Frame F = fresh(F0);
  const int k32 = F.lane & 31, half = F.lane >> 5;
  const float* sg = argp(F, 17) + 8 * k32;
  float g[8];
#pragma unroll
  for (int e = 0; e < 8; ++e) g[e] = sg[e] * (1.f - LAM_INIT2);
  for (int T = F.gw; T < TOK; T += F.NGW) {
    u32x4 raws[4];
#pragma unroll
    for (int it = 0; it < 4; ++it) raws[it] = LDG(u32x4, F.hbuf2 + (size_t)T * DM + (it * 2 + half) * 256 + 8 * k32);
    asm volatile("" ::: "memory");
#pragma unroll
    for (int it = 0; it < 4; ++it) { bf16_t* p = F.hbuf2 + (size_t)T * DM + (it * 2 + half) * 256 + 8 * k32;
      const u32x4 raw = raws[it];
      float x[8] = {bf_lo(raw.x), bf_hi(raw.x), bf_lo(raw.y), bf_hi(raw.y), bf_lo(raw.z), bf_hi(raw.z), bf_lo(raw.w), bf_hi(raw.w)};
      float ss = 0.f;
#pragma unroll
      for (int e = 0; e < 8; ++e) ss += x[e] * x[e];
      ss += swz_xor<1>(ss); ss += swz_xor<2>(ss); ss += swz_xor<4>(ss); ss += swz_xor<8>(ss); ss += swz_xor<16>(ss);
      const float rstd = 1.0f / sqrtf(ss * (1.f / 256.f) + EPS);
      u32x4 w; w.x = cvt_pk_bf16(x[0] * rstd * g[0], x[1] * rstd * g[1]); w.y = cvt_pk_bf16(x[2] * rstd * g[2], x[3] * rstd * g[3]);
      w.z = cvt_pk_bf16(x[4] * rstd * g[4], x[5] * rstd * g[5]); w.w = cvt_pk_bf16(x[6] * rstd * g[6], x[7] * rstd * g[7]);
      STG(u32x4, p) = w; }
  }
}

__device__ __forceinline__ Frame mkframe(LAS unsigned char* lds, int wave0) {
    Frame F; F.lds = lds;
    int tid = (wave0 << 6) | lane_id(); asm volatile("" : "+v"(tid));
    F.tid = tid; F.lane = tid & 63; F.wave = __builtin_amdgcn_readfirstlane(tid >> 6);
    int G = gridDim.x, bx = blockIdx.x; asm volatile("" : "+s"(G), "+s"(bx));
    F.G = G; F.vcu = (G % 8 == 0) ? (bx % 8) * (G / 8) + bx / 8 : bx;
    F.gw = F.vcu * NWAVES + F.wave; F.NGW = G * NWAVES;
    unsigned long long ka = (unsigned long long)__builtin_amdgcn_kernarg_segment_ptr(); asm volatile("" : "+s"(ka));
    F.kargs = ka;
    F.out = ((float* const __attribute__((address_space(4)))*)ka)[26]; unsigned char* ws = ((unsigned char* const __attribute__((address_space(4)))*)ka)[27];
    F.ws = ws; F.hbuf = (bf16_t*)(ws + WS_H) + (size_t)256 * DM; F.big = (bf16_t*)(ws + WS_BIG); F.mod = (float*)(ws + WS_MOD); F.lse = (float*)(ws + WS_LSE);
    F.hbuf2 = (bf16_t*)(ws + WS_H2); F.ssq = (float*)(ws + WS_SSQ); F.bias = (float*)(ws + WS_BIAS); F.xb = (bf16_t*)(ws + WS_XB);
    return F; }
__global__ void __launch_bounds__(NTHREADS, 2) fwd(Args args) {
    extern __shared__ __attribute__((aligned(16))) unsigned char lds_raw[];
    LAS unsigned char* const ldsb = (LAS unsigned char*)lds_raw;
    volatile LAS unsigned* MISC = (volatile LAS unsigned*)(ldsb + MISC_OFF);
    const int wave0 = __builtin_amdgcn_readfirstlane((int)threadIdx.x >> 6);
    if (threadIdx.x < 32) MISC[threadIdx.x] = 0u;
    __syncthreads();
    unsigned* barw = (unsigned*)(args.ws + WS_CTL) + CW_BAR;
    XcdBarrier bar; bar.bar = barw; bar.x = 0; bar.st = nullptr; bar.w0 = (unsigned)wave0;
    if (!MK_MULTI) bar = xcd_barrier_post(barw, MISC + 8, (unsigned)wave0);
    const int lo = args.ph_lo, hi = args.ph_hi;
#ifndef PHSEL
#define PHSEL(k) 1
#endif
#define IN(k) (PHSEL(k) && ({ int lo_ = lo, hi_ = hi; asm volatile("" : "+s"(lo_), "+s"(hi_)); lo_ <= (k) && (k) < hi_; }))
#define SEAM(k) do { if (!MK_MULTI) xcd_barrier(bar); } while (0)

    const bool SPREAD = (gridDim.x == 256);
    if (IN(0)) { phase_ropetab(mkframe(ldsb, wave0)); for (int rp = 0; rp < REPS(0); ++rp) { phase_mod(mkframe(ldsb, wave0)); __syncthreads(); phase_weights(mkframe(ldsb, wave0), SPREAD ? 1 : 15, 0, 0, 15); __syncthreads(); } SEAM(0); }

    for (int L0 = 0; L0 < 4; ++L0) {
        const int pb = 1 + 10 * L0;
#define LAYER_VARS() const Frame P = mkframe(ldsb, wave0); int L = L0; asm volatile("" : "+s"(L)); const float* modl = P.mod + (size_t)L * NB * 6 * DM; \
        const float* xin_p = (L == 0) ? argp(P, 0) : P.out; const float* xin_s = (L == 0) ? argp(P, 1) - (size_t)TOKP * DM : P.out; const int NQ = (L == 2) ? 4096 : 3072; (void)modl; (void)xin_p; (void)xin_s; (void)NQ
        if (L0 == 0 && IN(pb + 0)) { LAYER_VARS(); for (int rp = 0; rp < REPS(1); ++rp) { phase_bias(P, SPREAD ? 1 : 15, 0, 0, 3); phase_norm0(P, xin_p, xin_s, argp(P, 4), modl, 1, P.ssq); } SEAM(pb + 0); }
        if (IN(pb + 1)) { LAYER_VARS();
            pg8::Gemm g{P.hbuf, wt_ptr(P, L, WT_QKV), DM}; pg8::StaticOrder S; S.init(TOK / 256, NQ / 256, P.G, (int)blockIdx.x);
            pg8::EpiQKV E{P.big, NQ, 2048, (L == 0) ? 1.0f : QSCALE, P.ssq + (size_t)(2 * L) * SSQ_STRIDE, P.bias + (size_t)L * BIAS_L};
            for (int rp = 0; rp < REPS(2); ++rp) pg8::gemm_phase<pg8::EpiQKV, 0>(P.lds, g, S, E, STAG_QKV, P.tid);
            if (SPREAD && L < 2 && (int)blockIdx.x >= 128) { __syncthreads(); phase_weights(mkframe(ldsb, wave0), 2 << L, 128, 128, 15); }
            if (SPREAD && L == 3 && (int)blockIdx.x >= 128) { __syncthreads(); phase_bias(mkframe(ldsb, wave0), 8, 128, 128, 2); }
            SEAM(pb + 1);
        }
        if (L0 == 0) {
            if (IN(pb + 2)) { { const Frame P = mkframe(ldsb, wave0); phase_qknorm_rope<!NAIVE_A>(P, argp(P, 9), argp(P, 10)); } SEAM(pb + 2); }
#if NAIVE_A
            if (IN(pb + 3)) { phase_attn_naive<0>(mkframe(ldsb, wave0)); SEAM(pb + 3); }
#else
            if (IN(pb + 3)) { for (int rp = 0; rp < REPS(3) + REPS(6) - 1; ++rp) phase_attn_fast<0>(mkframe(ldsb, wave0)); SEAM(pb + 3); }
#endif
        } else if (L0 == 1) {
#if NAIVE_B
            if (IN(pb + 2)) { phase_attn_naive<1>(mkframe(ldsb, wave0)); SEAM(pb + 2); }
#else
            if (IN(pb + 2)) { for (int rp = 0; rp < REPS(3) + REPS(7) - 1; ++rp) phase_attn_fast<1>(mkframe(ldsb, wave0)); SEAM(pb + 2); }
#endif
        } else if (L0 == 2) {
#if NAIVE_C
            if (IN(pb + 2)) { phase_attn_naive<2>(mkframe(ldsb, wave0)); SEAM(pb + 2); }
#else
            if (IN(pb + 2)) { phase_kmax(mkframe(ldsb, wave0)); SEAM(pb + 2); for (int rp = 0; rp < REPS(3) + REPS(8) - 1; ++rp) phase_attn_c(mkframe(ldsb, wave0)); SEAM(pb + 2); }
#endif
        } else {
#if NAIVE_D
            if (IN(pb + 2)) { phase_attn_naive<3>(mkframe(ldsb, wave0)); SEAM(pb + 2); }
#else
            if (IN(pb + 2)) { for (int rp = 0; rp < REPS(3) + REPS(9) - 1; ++rp) phase_attn_fast<4>(mkframe(ldsb, wave0)); SEAM(pb + 2); }
            if (IN(pb + 3)) { phase_attn_fast<5>(mkframe(ldsb, wave0)); SEAM(pb + 3); }
            if (IN(pb + 4)) { phase_attn_fast<6>(mkframe(ldsb, wave0)); SEAM(pb + 4); }
#endif
        }
        if (IN(pb + 5)) { LAYER_VARS();
            pg8::Gemm g{P.hbuf2, wt_ptr(P, L, WT_WO), DM}; pg8::StaticOrder S; S.init(TOK / 256, DM / 256, P.G, (int)blockIdx.x);
            pg8::EpiRes<true> E{xin_p, xin_s, P.out, modl + 2 * DM, P.xb, P.hbuf, argp(P, 5) + L * DM, modl + 4 * DM, P.ssq + (size_t)(2 * L + 1) * SSQ_STRIDE};
            pg8::gemm_phase<pg8::EpiRes<true>, 0>(P.lds, g, S, E, STAG_WO, P.tid);
            SEAM(pb + 5);
        }
        if (IN(pb + 7)) { LAYER_VARS();
            pg8::Gemm g{P.hbuf, wt_ptr(P, L, WT_UP), DM}; pg8::StaticOrder S; S.init(163, DFF / 128, P.G, (int)blockIdx.x);
            pg8::EpiGLU E{P.big, argp(P, 22) + (size_t)L * 3 * DFF, argp(P, 23) + (size_t)L * DFF, P.ssq + (size_t)(2 * L + 1) * SSQ_STRIDE, P.bias + (size_t)L * BIAS_L + 12 * 4096};
            if (REPS(11) == 2) { pg8::EpiNull E0; pg8::gemm_phase<pg8::EpiNull, 1>(P.lds, g, S, E0, 0, P.tid); }
            for (int rp = 0; rp < REPS(5); ++rp) pg8::gemm_phase<pg8::EpiGLU, 1>(P.lds, g, S, E, STAG_UP, P.tid);
            if (SPREAD && L < 3 && (int)blockIdx.x >= 97) { __syncthreads();
                if (L < 2) phase_bias(mkframe(ldsb, wave0), 2 << L, 97, 159, 3);
                if (L == 1) phase_bias(mkframe(ldsb, wave0), 8, 97, 159, 1);
                __syncthreads();
                phase_weights(mkframe(ldsb, wave0), 8, 97, 159, L == 0 ? 3 : L == 1 ? 8 : 4); }
            SEAM(pb + 7);
        }
        if (IN(pb + 8)) { LAYER_VARS();
            pg8::Gemm g{P.big, wt_ptr(P, L, WT_DOWN), DFF}; pg8::StaticOrder S; S.init(TOK / 256, DM / 256, P.G, (int)blockIdx.x, 4);
            if (L < 3) { pg8::EpiRes<true> E{P.out, P.out, P.out, modl + 5 * DM, P.xb, P.hbuf, argp(P, 4) + (L + 1) * DM, modl + NB * 6 * DM + 1 * DM, P.ssq + (size_t)(2 * L + 2) * SSQ_STRIDE};
                pg8::gemm_phase<pg8::EpiRes<true>, 0>(P.lds, g, S, E, STAG_DOWN, P.tid); }
            else { pg8::EpiRes<false> E{P.out, P.out, P.out, modl + 5 * DM, P.xb, nullptr, nullptr, nullptr, nullptr};
                pg8::gemm_phase<pg8::EpiRes<false>, 0>(P.lds, g, S, E, STAG_DOWN, P.tid); }
            SEAM(pb + 8);
        }
#undef LAYER_VARS
    }
    if (IN(41)) { const Frame P = mkframe(ldsb, wave0); phase_final_norm(P, argp(P, 25)); }
#undef IN
#undef SEAM
}

extern "C" void kernel_launch(void* const* d_in, const int* in_sizes, int n_in, void* d_out, int out_size, void* d_ws, size_t ws_size, hipStream_t stream) {
    static int grid = 0;
    if (grid == 0) {
        if (n_in != 26 || out_size != TOK * DM || ws_size < WS_END) { fprintf(stderr, "kernel_launch: unexpected shapes (n_in %d out %d ws %zu)\n", n_in, out_size, ws_size); grid = -1; return; }
        int dev = 0, cus = 0, per_cu = 0;
        if (hipGetDevice(&dev) != hipSuccess || hipDeviceGetAttribute(&cus, hipDeviceAttributeMultiprocessorCount, dev) != hipSuccess) { grid = -1; return; }
        if (hipFuncSetAttribute((const void*)fwd, hipFuncAttributeMaxDynamicSharedMemorySize, LDS_BYTES) != hipSuccess) { fprintf(stderr, "kernel_launch: hipFuncSetAttribute failed\n"); grid = -1; return; }
        if (hipOccupancyMaxActiveBlocksPerMultiprocessor(&per_cu, (const void*)fwd, NTHREADS, LDS_BYTES) != hipSuccess || per_cu < 1) fprintf(stderr, "kernel_launch: occupancy query says %d\n", per_cu);
        (void)hipGetLastError();
        grid = cus;
    }
    if (grid < 0) return;
    (void)hipMemsetAsync((char*)d_ws + WS_CTL, 0, CTL_ZERO_BYTES, stream);
    Args a{};
    for (int i = 0; i < 26; ++i) a.in[i] = (const float*)d_in[i];
    a.out = (float*)d_out; a.ws = (unsigned char*)d_ws;
#if MK_MULTI
    for (int p = 0; p < 42; ++p) {
        const int r = (p - 1) % 10, L = (p - 1) / 10;
        if (p >= 1 && p <= 40) { if (r == 9 || r == 6 || (r == 0 && L != 0)) continue; if (r == 4 && !(L == 3 && !NAIVE_D)) continue; if (r == 3 && !(L == 0 || (L == 3 && !NAIVE_D))) continue; }
        a.ph_lo = p; a.ph_hi = p + 1;
        hipLaunchKernelGGL(fwd, dim3(grid), dim3(NTHREADS), LDS_BYTES, stream, a);
    }
#else
    a.ph_lo = 0; a.ph_hi = 42;
    hipLaunchKernelGGL(fwd, dim3(grid), dim3(NTHREADS), LDS_BYTES, stream, a);
#endif
}
```
